# Optimizing an MI355X kernel written in HIP

```python
import math
import jax, jax.numpy as jnp
from jax import lax
import numpy as np

D_MODEL = 1024
BATCH = 8
SEQ = 2048
DEPTH = 2
DEC_BATCH = 128
DEC_SEQ = 1
PAST_LEN = 16384
PAGE_SIZE = 128

N_MIXERS = 2
N_S5_LAYERS = (DEPTH + 1) // 2
N_CONV_LAYERS = DEPTH // 2
S5_WIDTH = D_MODEL
S5_GROUP_CH = 16
S5_GROUPS = S5_WIDTH // S5_GROUP_CH
S5_STATE = 64
D_CONV = D_MODEL
CONV_W = 3
D_FF = 2816
ALPHA = (2.0 * DEPTH) ** 0.25
BETA = (8.0 * DEPTH) ** -0.25
LN_EPS = 1e-5

kernel_name = "hybrid_s5_shortconv_convffn_decode_step"


def layer_norm(x, g, b):
    xf = x.astype(jnp.float32)
    mu = jnp.mean(xf, axis=-1, keepdims=True)
    var = jnp.mean(jnp.square(xf - mu), axis=-1, keepdims=True)
    return ((xf - mu) * lax.rsqrt(var + LN_EPS) * g.astype(jnp.float32) + b.astype(jnp.float32)).astype(x.dtype)


def modulate(x, shift, scale):
    return x * (1.0 + scale[:, None, :]) + shift[:, None, :]


def causal_dwconv(v, buf, w):
    seq = v.shape[1]
    cat = jnp.concatenate([buf.astype(v.dtype), v], axis=1)
    out = sum(w[k] * cat[:, k:k + seq] for k in range(CONV_W))
    return out, cat[:, -(CONV_W - 1):]


def _lin_combine(e1, e2):
    a1, b1 = e1
    a2, b2 = e2
    return a2 * a1, a2 * b1 + b2


def s5_mixer(h, h0_re, h0_im, w_in, lam_re, lam_im, log_dt, b_re, b_im, c_re, c_im, d_skip, w_glu):
    n, seq, _ = h.shape
    f32 = jnp.float32
    u = (h @ w_in).astype(f32).reshape(n, seq, S5_GROUPS, S5_GROUP_CH)
    lam = lax.complex(lam_re.astype(f32), lam_im.astype(f32))
    dt = jnp.exp(log_dt.astype(f32))[:, None]
    a_bar = jnp.exp(lam * dt)
    b_bar = ((a_bar - 1.0) / lam)[..., None] * lax.complex(b_re.astype(f32), b_im.astype(f32))
    bu = jnp.einsum('nlgc,gpc->nlgp', u.astype(jnp.complex64), b_bar)
    h0 = lax.complex(h0_re.astype(f32), h0_im.astype(f32))
    bu = bu.at[:, 0].add(a_bar * h0)
    a_seq = jnp.broadcast_to(a_bar, bu.shape)
    _, states = lax.associative_scan(_lin_combine, (a_seq, bu), axis=1)
    y = (jnp.einsum('nlgp,gcp->nlgc', states.real, c_re.astype(f32))
         - jnp.einsum('nlgp,gcp->nlgc', states.imag, c_im.astype(f32)))
    y = (y + d_skip.astype(f32).reshape(S5_GROUPS, S5_GROUP_CH) * u).reshape(n, seq, S5_WIDTH)
    y = jax.nn.gelu(y).astype(h.dtype)
    z = y @ w_glu
    out = z[..., :D_MODEL] * jax.nn.sigmoid(z[..., D_MODEL:])
    last = states[:, -1]
    return out, last.real, last.imag


def short_conv_mixer(h, buf, w_in, conv_w, w_out):
    z = h @ w_in
    gate_b, gate_c, v = z[..., :D_CONV], z[..., D_CONV:2 * D_CONV], z[..., 2 * D_CONV:]
    conv_out, new_buf = causal_dwconv(gate_c * v, buf, conv_w)
    return (gate_b * conv_out) @ w_out, new_buf


def conv_ffn(h, buf, w_up, conv_w, conv_b, w_down):
    up = h @ w_up
    conv_out, new_buf = causal_dwconv(up, buf, conv_w)
    conv_out = conv_out + conv_b
    val, gate = conv_out[..., :D_FF], conv_out[..., D_FF:]
    return (jax.nn.gelu(gate) * val) @ w_down, new_buf


def trunk(x, c, s5_re, s5_im, conv_buf, ffn_buf, p):
    n = c.shape[0]
    mods = (jax.nn.silu(c) @ p['w_ada'] + p['b_ada']).reshape(n, DEPTH, 2, 3, D_MODEL)
    new_re, new_im, new_conv, new_ffn = [], [], [], []
    for i in range(DEPTH):
        shift, scale, gate = mods[:, i, 0, 0], mods[:, i, 0, 1], mods[:, i, 0, 2]
        h = modulate(x, shift, scale)
        if i % N_MIXERS == 0:
            a = i // N_MIXERS
            m, st_re, st_im = s5_mixer(h, s5_re[a], s5_im[a], p['s5_w_in'][a], p['s5_lam_re'][a], p['s5_lam_im'][a],
                                       p['s5_log_dt'][a], p['s5_b_re'][a], p['s5_b_im'][a], p['s5_c_re'][a],
                                       p['s5_c_im'][a], p['s5_d'][a], p['s5_w_glu'][a])
            new_re.append(st_re)
            new_im.append(st_im)
        else:
            b = i // N_MIXERS
            m, nb = short_conv_mixer(h, conv_buf[b], p['sc_w_in'][b], p['sc_conv_w'][b], p['sc_w_out'][b])
            new_conv.append(nb)
        x = layer_norm(ALPHA * x + gate[:, None, :] * m, p['ln_g'][i, 0], p['ln_b'][i, 0])
        shift, scale, gate = mods[:, i, 1, 0], mods[:, i, 1, 1], mods[:, i, 1, 2]
        h = modulate(x, shift, scale)
        f, fb = conv_ffn(h, ffn_buf[i], p['ffn_w_up'][i], p['ffn_conv_w'][i], p['ffn_conv_b'][i], p['ffn_w_down'][i])
        new_ffn.append(fb)
        x = layer_norm(ALPHA * x + gate[:, None, :] * f, p['ln_g'][i, 1], p['ln_b'][i, 1])
    return x, jnp.stack(new_re), jnp.stack(new_im), jnp.stack(new_conv), jnp.stack(new_ffn)


def setup_inputs(seed: int = 0) -> dict:
    key = jax.random.key(seed)
    ks = jax.random.split(key, 32)
    f32 = jnp.float32

    def nrm(k, shape, std):
        return (jax.random.normal(k, shape, f32) * std).astype(f32)

    d = D_MODEL
    lam_im = (jnp.pi * jnp.arange(S5_STATE, dtype=f32))[None, None, :] + nrm(ks[10], (N_S5_LAYERS, S5_GROUPS, S5_STATE), 0.01)
    sc_w_in = nrm(ks[20], (N_CONV_LAYERS, d, 3 * D_CONV), d ** -0.5)
    sc_w_in = sc_w_in * jnp.concatenate([jnp.ones((2 * D_CONV,), f32), jnp.full((D_CONV,), BETA, f32)])
    ffn_w_up = nrm(ks[23], (DEPTH, d, 2 * D_FF), d ** -0.5)
    ffn_w_up = ffn_w_up * jnp.concatenate([jnp.full((D_FF,), BETA, f32), jnp.ones((D_FF,), f32)])
    s5_w_glu = nrm(ks[17], (N_S5_LAYERS, S5_WIDTH, 2 * d), S5_WIDTH ** -0.5)
    s5_w_glu = s5_w_glu * jnp.concatenate([jnp.full((d,), BETA, f32), jnp.ones((d,), f32)])
    return {
        'x_prompt': nrm(ks[0], (BATCH, SEQ, d), 1.0),
        'x_sample': nrm(ks[1], (DEC_BATCH, DEC_SEQ, d), 1.0),
        'c_prompt': nrm(ks[2], (BATCH, d), 1.0),
        'c_sample': nrm(ks[3], (DEC_BATCH, d), 1.0),
        'state_s5_re': nrm(ks[4], (N_S5_LAYERS, DEC_BATCH, S5_GROUPS, S5_STATE), 0.5),
        'state_s5_im': nrm(ks[5], (N_S5_LAYERS, DEC_BATCH, S5_GROUPS, S5_STATE), 0.5),
        'state_conv': nrm(ks[6], (N_CONV_LAYERS, DEC_BATCH, CONV_W - 1, D_CONV), 1.0),
        'state_ffn': nrm(ks[7], (DEPTH, DEC_BATCH, CONV_W - 1, 2 * D_FF), 0.7),
        'w_ada': nrm(ks[8], (d, DEPTH * 2 * 3 * d), d ** -0.5),
        'b_ada': nrm(ks[9], (DEPTH * 2 * 3 * d,), 0.02),
        's5_w_in': nrm(ks[11], (N_S5_LAYERS, d, S5_WIDTH), BETA * d ** -0.5),
        's5_lam_re': -0.5 + nrm(ks[12], (N_S5_LAYERS, S5_GROUPS, S5_STATE), 0.01),
        's5_lam_im': lam_im,
        's5_log_dt': jax.random.uniform(ks[13], (N_S5_LAYERS, S5_GROUPS), f32, math.log(1e-3), math.log(1e-1)),
        's5_b_re': nrm(ks[14], (N_S5_LAYERS, S5_GROUPS, S5_STATE, S5_GROUP_CH), (2.0 * S5_GROUP_CH) ** -0.5),
        's5_b_im': nrm(ks[15], (N_S5_LAYERS, S5_GROUPS, S5_STATE, S5_GROUP_CH), (2.0 * S5_GROUP_CH) ** -0.5),
        's5_c_re': nrm(ks[16], (N_S5_LAYERS, S5_GROUPS, S5_GROUP_CH, S5_STATE), (2.0 * S5_STATE) ** -0.5),
        's5_c_im': nrm(ks[18], (N_S5_LAYERS, S5_GROUPS, S5_GROUP_CH, S5_STATE), (2.0 * S5_STATE) ** -0.5),
        's5_d': nrm(ks[19], (N_S5_LAYERS, S5_WIDTH), 1.0),
        's5_w_glu': s5_w_glu,
        'sc_w_in': sc_w_in,
        'sc_conv_w': nrm(ks[21], (N_CONV_LAYERS, CONV_W, D_CONV), CONV_W ** -0.5),
        'sc_w_out': nrm(ks[22], (N_CONV_LAYERS, D_CONV, d), BETA * D_CONV ** -0.5),
        'ffn_w_up': ffn_w_up,
        'ffn_conv_w': nrm(ks[24], (DEPTH, CONV_W, 2 * D_FF), CONV_W ** -0.5),
        'ffn_conv_b': nrm(ks[25], (DEPTH, 2 * D_FF), 0.02),
        'ffn_w_down': nrm(ks[26], (DEPTH, D_FF, d), BETA * D_FF ** -0.5),
        'ln_g': 1.0 + nrm(ks[27], (DEPTH, 2, d), 0.02),
        'ln_b': nrm(ks[28], (DEPTH, 2, d), 0.02),
    }


def reference(x_prompt, x_sample, c_prompt, c_sample, state_s5_re, state_s5_im, state_conv, state_ffn,
              w_ada, b_ada, s5_w_in, s5_lam_re, s5_lam_im, s5_log_dt, s5_b_re, s5_b_im, s5_c_re, s5_c_im,
              s5_d, s5_w_glu, sc_w_in, sc_conv_w, sc_w_out, ffn_w_up, ffn_conv_w, ffn_conv_b, ffn_w_down,
              ln_g, ln_b):
    p = {'w_ada': w_ada, 'b_ada': b_ada, 's5_w_in': s5_w_in, 's5_lam_re': s5_lam_re, 's5_lam_im': s5_lam_im,
         's5_log_dt': s5_log_dt, 's5_b_re': s5_b_re, 's5_b_im': s5_b_im, 's5_c_re': s5_c_re, 's5_c_im': s5_c_im,
         's5_d': s5_d, 's5_w_glu': s5_w_glu, 'sc_w_in': sc_w_in, 'sc_conv_w': sc_conv_w, 'sc_w_out': sc_w_out,
         'ffn_w_up': ffn_w_up, 'ffn_conv_w': ffn_conv_w, 'ffn_conv_b': ffn_conv_b, 'ffn_w_down': ffn_w_down,
         'ln_g': ln_g, 'ln_b': ln_b}
    nb = x_prompt.shape[0]
    z_s5 = jnp.zeros((N_S5_LAYERS, nb, S5_GROUPS, S5_STATE), jnp.float32)
    z_conv = jnp.zeros((N_CONV_LAYERS, nb, CONV_W - 1, D_CONV), x_prompt.dtype)
    z_ffn = jnp.zeros((DEPTH, nb, CONV_W - 1, 2 * D_FF), x_prompt.dtype)
    y_prompt, s5re_p, s5im_p, conv_p, ffn_p = trunk(x_prompt, c_prompt, z_s5, z_s5, z_conv, z_ffn, p)
    y_sample, s5re_s, s5im_s, conv_s, ffn_s = trunk(x_sample, c_sample, state_s5_re, state_s5_im,
                                                    state_conv, state_ffn, p)
    return (y_prompt, y_sample, s5re_p, s5im_p, s5re_s, s5im_s, conv_p, conv_s, ffn_p, ffn_s)
```

```cpp
#include <hip/hip_runtime.h>
#include <hip/hip_cooperative_groups.h>
#include <cstdio>
namespace cg = cooperative_groups;

#ifndef ONE_LAUNCH
#define ONE_LAUNCH 1
#endif

#ifndef REPMASK
#define REPMASK 0u
#endif
#ifndef SKREP
#define SKREP 1
#endif
#ifndef S5P_REP
#define S5P_REP 1
#endif
#ifndef S5S_REP
#define S5S_REP 1
#endif
#ifndef XSYNC
#define XSYNC 0
#endif
#define LAS __attribute__((address_space(3)))
typedef unsigned short bf16_t;
typedef short bf16x8 __attribute__((ext_vector_type(8)));
typedef float f32x4 __attribute__((ext_vector_type(4)));
typedef unsigned u32x4 __attribute__((ext_vector_type(4)));
typedef unsigned u32x2 __attribute__((ext_vector_type(2)));

constexpr int D = 1024, SEQ = 2048, NB = 8, MP = NB * SEQ, NS = 128, MT = MP + NS;
constexpr int DFF = 2816, DFF2 = 5632, NMOD = 12288;
constexpr float ALPHA = 1.41421356237309515f;
constexpr float LN_EPS = 1e-5f;
constexpr int NTHR = 512;
constexpr int LDS_BYTES = 131072 + 2048;
constexpr int NPHASE = 19;

constexpr size_t WS_WIN = 0;
constexpr size_t WS_WGLU = WS_WIN + (size_t)1024 * 1024 * 2;
constexpr size_t WS_SCIN = WS_WGLU + (size_t)2048 * 1024 * 2;
constexpr size_t WS_SCOUT = WS_SCIN + (size_t)3072 * 1024 * 2;
constexpr size_t WS_UP = WS_SCOUT + (size_t)1024 * 1024 * 2;
constexpr size_t WS_DOWN = WS_UP + (size_t)2 * 5632 * 1024 * 2;
constexpr size_t WS_H = WS_DOWN + (size_t)2 * 1024 * 2816 * 2;
constexpr size_t WS_T = WS_H + (size_t)MT * 1024 * 2;
constexpr size_t WS_BIG = WS_T + (size_t)MT * 1024 * 4;
constexpr size_t BIG_TAB1 = 0;
constexpr size_t BIG_TAB2 = BIG_TAB1 + (size_t)64 * 128 * 256 * 2;
constexpr size_t BIG_SLOC = BIG_TAB2 + (size_t)64 * 256 * 384 * 2;
constexpr size_t BIG_HALO = (size_t)MT * 2816 * 2;
constexpr size_t WS_MODS = WS_BIG + BIG_HALO + (size_t)128 * 4 * 5632 * 2;
constexpr size_t WS_RAW = WS_MODS + (size_t)136 * NMOD * 4;
constexpr size_t WS_AC = WS_RAW + (size_t)4 * 128 * 3072 * 4;
constexpr size_t WS_S5C = WS_AC + (size_t)144 * 1024 * 2;
constexpr size_t WS_BBAR = WS_S5C + (size_t)64 * 64 * 8 * 4;
constexpr size_t WS_BAR = WS_BBAR + (size_t)64 * 64 * 32 * 4;
constexpr size_t WS_CNT = WS_BAR + 16384;
constexpr size_t WS_XBUF = WS_CNT + 16384;
constexpr size_t WS_STATS = WS_XBUF + (size_t)64 * 256 * 4 * 8;
constexpr size_t WS_END = WS_STATS + (size_t)MP * 8;

constexpr size_t O_Y = 0;
constexpr size_t O_S5RE_P = (size_t)MT * 1024;
constexpr size_t O_S5IM_P = O_S5RE_P + 8 * 64 * 64;
constexpr size_t O_S5RE_S = O_S5IM_P + 8 * 64 * 64;
constexpr size_t O_S5IM_S = O_S5RE_S + 128 * 64 * 64;
constexpr size_t O_CONV_P = O_S5IM_S + 128 * 64 * 64;
constexpr size_t O_CONV_S = O_CONV_P + 8 * 2 * 1024;
constexpr size_t O_FFN_P = O_CONV_S + 128 * 2 * 1024;
constexpr size_t O_FFN_S = O_FFN_P + (size_t)2 * 8 * 2 * 5632;
constexpr size_t O_END = O_FFN_S + (size_t)2 * 128 * 2 * 5632;

struct Params {
    const float *x_p, *x_s, *c_p, *c_s, *s5re, *s5im, *st_conv, *st_ffn, *w_ada, *b_ada, *s5_w_in, *lam_re, *lam_im, *log_dt,
        *b_re, *b_im, *c_re, *c_im, *s5_d, *w_glu, *sc_w_in, *sc_conv_w, *sc_w_out, *ffn_w_up, *ffn_conv_w, *ffn_conv_b, *ffn_w_down, *ln_g, *ln_b;
    float* out; unsigned char* ws; int ph_lo, ph_hi;
};
typedef const Params __attribute__((address_space(4))) KP;
__device__ __forceinline__ KP& getP() { KP* p = (KP*)__builtin_amdgcn_kernarg_segment_ptr(); asm volatile("" : "+s"(p)); return *p; }

__device__ __forceinline__ unsigned cvt_pk_bf16(float lo, float hi) { unsigned r; asm volatile("v_cvt_pk_bf16_f32 %0, %1, %2" : "=v"(r) : "v"(lo), "v"(hi)); return r; }
__device__ __forceinline__ float bf2f(unsigned short b) { return __uint_as_float(((unsigned)b) << 16); }
__device__ __forceinline__ float bflo(unsigned w) { return __uint_as_float(w << 16); }
__device__ __forceinline__ float bfhi(unsigned w) { return __uint_as_float(w & 0xffff0000u); }
__device__ __forceinline__ float sigmoidf_(float x) { return __builtin_amdgcn_rcpf(1.0f + __builtin_amdgcn_exp2f(-1.44269504089f * x)); }
__device__ __forceinline__ float gelu_tanh(float x) { const float u = 1.5957691216057308f * (x + 0.044715f * x * x * x); return x * sigmoidf_(u); }
typedef float f32x2 __attribute__((ext_vector_type(2)));
__device__ __forceinline__ f32x2 gelu2(f32x2 x) {
    f32x2 z = x * (x * x * (-0.10294324f) + (-2.302208198f));
    z.x = fminf(z.x, 60.f); z.y = fminf(z.y, 60.f);
    f32x2 d; d.x = __builtin_amdgcn_exp2f(z.x); d.y = __builtin_amdgcn_exp2f(z.y); d = d + 1.0f;
    const float r = __builtin_amdgcn_rcpf(d.x * d.y);
    return x * ((f32x2){d.y, d.x} * r);
}
__device__ __forceinline__ int pcol(int c) { return ((c >> 7) << 8) + (c & 127); }
template <int CTRL> __device__ __forceinline__ float dppx(float x) { return __builtin_bit_cast(float, __builtin_amdgcn_update_dpp(0, __builtin_bit_cast(int, x), CTRL, 0xf, 0xf, false)); }
__device__ __forceinline__ float wave_sum(float v) {
    v += dppx<0xB1>(v); v += dppx<0x4E>(v); v += dppx<0x141>(v); v += dppx<0x140>(v);
    v += __shfl_xor(v, 16); v += __shfl_xor(v, 32);
    return v;
}
template <int CTRL> __device__ __forceinline__ float dppf(float x) { return __builtin_bit_cast(float, __builtin_amdgcn_update_dpp(0, __builtin_bit_cast(int, x), CTRL, 0xf, 0xf, false)); }

extern __shared__ __attribute__((aligned(16))) unsigned char lds_raw[];
constexpr int LDS_WTAB = 131072 + 256;
__device__ __forceinline__ int ltid() {
    const unsigned slot = (unsigned)__builtin_amdgcn_s_getreg((5 << 11) | 4) & 63u;
    const int w = __builtin_amdgcn_readfirstlane(((volatile LAS int*)((LAS unsigned char*)lds_raw + LDS_WTAB))[slot]);
    int ln_; asm volatile("v_mbcnt_lo_u32_b32 %0, -1, 0\n\tv_mbcnt_hi_u32_b32 %0, -1, %0" : "=v"(ln_));
    int t = (w << 6) | ln_;
    asm volatile("" : "+v"(t));
    return t;
}
__device__ __forceinline__ void cis_d(double x, double& s, double& c) {
    const double k = rint(x * 0.63661977236758134308);
    double r = fma(-k, 1.57079632679489655800e+00, x); r = fma(-k, 6.12323399573676603587e-17, r);
    const double r2 = r * r;
    const double sp = r * (1.0 + r2 * (-1.0 / 6.0 + r2 * (1.0 / 120.0 + r2 * (-1.0 / 5040.0 + r2 * (1.0 / 362880.0 + r2 * (-1.0 / 39916800.0 + r2 * (1.0 / 6227020800.0)))))));
    const double cp = 1.0 + r2 * (-0.5 + r2 * (1.0 / 24.0 + r2 * (-1.0 / 720.0 + r2 * (1.0 / 40320.0 + r2 * (-1.0 / 3628800.0 + r2 * (1.0 / 479001600.0 + r2 * (-1.0 / 87178291200.0)))))));
    const int q = ((int)k) & 3;
    s = (q == 0) ? sp : (q == 1) ? cp : (q == 2) ? -sp : -cp;
    c = (q == 0) ? cp : (q == 1) ? -sp : (q == 2) ? -cp : sp;
}
__device__ __forceinline__ void apow_d(KP& P, int g, int p, double e, double& ar, double& ai) {
    const double lr = (double)P.lam_re[g * 64 + p], li = (double)P.lam_im[g * 64 + p], dt = exp((double)P.log_dt[g]);
    const double mag = exp(e * lr * dt); double s, c; cis_d(e * li * dt, s, c); ar = mag * c; ai = mag * s;
}
__device__ __forceinline__ void bcoef_d(KP& P, int g, int p, double& cr, double& ci) {
    const double lr = (double)P.lam_re[g * 64 + p], li = (double)P.lam_im[g * 64 + p];
    double ar, ai; apow_d(P, g, p, 1.0, ar, ai);
    const double nr = ar - 1.0, ni = ai, den = lr * lr + li * li;
    cr = (nr * lr + ni * li) / den; ci = (ni * lr - nr * li) / den;
}

constexpr int BM = 256, BK = 64, HALF = 128, HTB = HALF * BK * 2, NXCD = 8, WGM = 4;
__device__ __forceinline__ int lds_byte(int r, int c) { const int st = (r >> 4) * 2 + (c >> 5), rr = r & 15, cc = c & 31, ob = rr * 64 + cc * 2; return st * 1024 + (ob ^ (((ob >> 9) & 1) << 5)); }
__device__ __forceinline__ void stage_rc(int b, int& R, int& C) { const int st = b / 1024, sb = b % 1024, swz = sb ^ (((sb >> 9) & 1) << 5); R = (st >> 1) * 16 + swz / 64; C = (st & 1) * 32 + (swz % 64) / 2; }
__device__ __forceinline__ int perm32(int rho) { const int n = rho >> 4, i = rho & 15; return 8 * (i >> 2) + 4 * n + (i & 3); }

struct Unit { int pm, pn; };
struct Gemm { const bf16_t* A; const bf16_t* Bt; int lda, ldb, K; };
struct StaticOrder {
    int nM, nN, nwg, G, c, wg;
    __device__ __forceinline__ void init(int M, int N, int G_, int c_) { nM = M / BM; nN = N / BM; nwg = nM * nN; G = G_; c = c_; wg = (nN == 8) ? 1 : (nN > 12 ? 1 : WGM); }
    __device__ __forceinline__ bool next(int i, Unit& u) const {
        const long L = (long)i * G + c; if (L >= nwg) return false;
        int wgid = (int)L; { const int q = nwg / NXCD, r = nwg % NXCD, xcd = wgid % NXCD, off = wgid / NXCD; wgid = (xcd < r ? xcd * (q + 1) : r * (q + 1) + (xcd - r) * q) + off; }
        const int nig = wg * nN, gid = wgid / nig, fm = gid * wg, gsz = (nM - fm) < wg ? (nM - fm) : wg;
        u.pm = fm + ((wgid % nig) % gsz); u.pn = (wgid % nig) / gsz; return true;
    }
};
struct OneUnit { Unit u; __device__ __forceinline__ bool next(int i, Unit& o) const { if (i) return false; o = u; return true; } };

template <class Epi, class Sched>
__device__ __forceinline__ void gemm_phase(LAS unsigned char* lds, const Gemm g, const Sched& S, Epi& E) {
    const int tid = ltid(), wid = __builtin_amdgcn_readfirstlane(tid >> 6), lane = tid & 63, wr = wid >> 2, wc = wid & 3, fr = lane & 15, fq = lane >> 4;
    const int K = g.K, nt = K / BK;
    unsigned voffA[2], voffB[2];
#pragma unroll
    for (int i = 0; i < 2; ++i) { int R, C; stage_rc(tid * 16 + i * 8192, R, C); const int Rb = Epi::PERM ? ((R & ~31) + perm32(R & 31)) : R; const int Ra = Epi::RPERM ? (R + 64 * (R >> 6)) : R;
        voffA[i] = (Epi::AMODE == 1) ? (unsigned)((C >> 4) * (MP * 16) + Ra * 16 + (C & 15)) * 2u : (unsigned)(Ra * g.lda + C) * 2u; voffB[i] = (unsigned)(Rb * g.ldb + C) * 2u; }
    const size_t kstep = (size_t)(BK * 2);
    const size_t kstepA = (Epi::AMODE == 1) ? (size_t)4 * MP * 16 * 2 : kstep;
    const size_t hstepA = (Epi::AMODE == 1) ? (size_t)128 * 16 * 2 : (size_t)(Epi::RPERM ? 64 : 128) * g.lda * 2, hstepB = (size_t)HALF * g.ldb * 2;
    const size_t tstepA = (Epi::AMODE == 1) ? (size_t)BM * 16 * 2 : (size_t)BM * g.lda * 2, tstepB = (size_t)BM * g.ldb * 2;
    const unsigned ldsw = (unsigned)wid * 1024u;
    const int aoff = lds_byte(wr * 64 + fr, fq * 8), boff = lds_byte(wc * 32 + fr, fq * 8);
#define PG8_SA(b, h) (((b) * 2 + (h)) * HTB)
#define PG8_SB(b, h) ((4 + (b) * 2 + (h)) * HTB)
#define PG8_STAGE(bufoff, gbase, voff) do { _Pragma("unroll") for (int _i = 0; _i < 2; ++_i) \
        __builtin_amdgcn_global_load_lds((const unsigned*)((const char*)(gbase) + (voff)[_i]), (LAS unsigned*)(lds + (bufoff) + ldsw + _i * 8192), 16, 0, 0); } while (0)
#define PG8_LDA(dst, b, h) do { _Pragma("unroll") for (int m = 0; m < 4; ++m) _Pragma("unroll") for (int k = 0; k < 2; ++k) dst[m][k] = *(const LAS bf16x8*)(lds + PG8_SA(b, h) + aoff + m * 2048 + k * 1024); } while (0)
#define PG8_LDB(dst, b, h) do { _Pragma("unroll") for (int n = 0; n < 2; ++n) _Pragma("unroll") for (int k = 0; k < 2; ++k) dst[n][k] = *(const LAS bf16x8*)(lds + PG8_SB(b, h) + boff + n * 2048 + k * 1024); } while (0)
#define PG8_MMA(ai, bj, At, Bt) do { __builtin_amdgcn_s_setprio(1); _Pragma("unroll") for (int m = 0; m < 4; ++m) _Pragma("unroll") for (int n = 0; n < 2; ++n) _Pragma("unroll") for (int k = 0; k < 2; ++k) \
        acc[ai][bj][m][n] = __builtin_amdgcn_mfma_f32_16x16x32_bf16(Bt[n][k], At[m][k], acc[ai][bj][m][n], 0, 0, 0); __builtin_amdgcn_s_setprio(0); } while (0)
#define PG8_WAIT_V(n) asm volatile("s_waitcnt vmcnt(" #n ")" ::: "memory")
#define PG8_WAIT_L(n) asm volatile("s_waitcnt lgkmcnt(" #n ")" ::: "memory")
#define PG8_BAR __builtin_amdgcn_s_barrier()
#define PG8_SCHED __builtin_amdgcn_sched_barrier(0)
    Unit cur, nxt; int ui = 0;
    if (!S.next(0, cur)) return;
    f32x4 acc[2][2][4][2];
#pragma unroll
    for (int a = 0; a < 2; ++a)
#pragma unroll
        for (int b = 0; b < 2; ++b)
#pragma unroll
            for (int m = 0; m < 4; ++m)
#pragma unroll
                for (int n = 0; n < 2; ++n) acc[a][b][m][n] = (f32x4){0.f, 0.f, 0.f, 0.f};
    bf16x8 At[4][2], B0[2][2], B1[2][2];
    const char* cA = (const char*)g.A + (size_t)cur.pm * tstepA; const char* cB = (const char*)g.Bt + (size_t)cur.pn * tstepB;
    PG8_STAGE(PG8_SB(0, 0), cB, voffB); PG8_STAGE(PG8_SA(0, 0), cA, voffA); PG8_STAGE(PG8_SB(0, 1), cB + hstepB, voffB); PG8_STAGE(PG8_SA(0, 1), cA + hstepA, voffA);
    if (wr == 1) PG8_BAR;
    PG8_WAIT_V(4); PG8_BAR;
    PG8_STAGE(PG8_SB(1, 0), cB + kstep, voffB); PG8_STAGE(PG8_SA(1, 0), cA + kstepA, voffA); PG8_STAGE(PG8_SB(1, 1), cB + hstepB + kstep, voffB);
    PG8_WAIT_V(6); PG8_BAR;
    for (;;) {
        const bool has_next = S.next(ui + 1, nxt);
        const char* nA = has_next ? (const char*)g.A + (size_t)nxt.pm * tstepA : cA; const char* nB = has_next ? (const char*)g.Bt + (size_t)nxt.pn * tstepB : cB;
        for (int t = 0; t < nt; t += 2) {
            const bool last = (t == nt - 2);
            const char* a1 = cA + (size_t)(t + 1) * kstepA;
            const char* a2 = last ? nA : cA + (size_t)(t + 2) * kstepA; const char* b2 = last ? nB : cB + (size_t)(t + 2) * kstep;
            const char* a3 = a2 + kstepA; const char* b3 = b2 + kstep;
            PG8_LDB(B0, 0, 0); PG8_SCHED; PG8_LDA(At, 0, 0); PG8_STAGE(PG8_SA(1, 1), a1 + hstepA, voffA);
            PG8_WAIT_L(8); PG8_BAR; PG8_WAIT_L(0); PG8_MMA(0, 0, At, B0); PG8_BAR; PG8_SCHED;
            PG8_LDB(B1, 0, 1); PG8_STAGE(PG8_SB(0, 0), b2, voffB);
            PG8_BAR; PG8_WAIT_L(0); PG8_MMA(0, 1, At, B1); PG8_BAR;
            PG8_LDA(At, 0, 1); PG8_STAGE(PG8_SA(0, 0), a2, voffA);
            PG8_BAR; PG8_WAIT_L(0); PG8_MMA(1, 0, At, B0); PG8_BAR; PG8_SCHED;
            PG8_STAGE(PG8_SB(0, 1), b2 + hstepB, voffB);
            PG8_WAIT_V(6); PG8_BAR; PG8_MMA(1, 1, At, B1); PG8_BAR;
            PG8_LDB(B0, 1, 0); PG8_SCHED; PG8_LDA(At, 1, 0); PG8_STAGE(PG8_SA(0, 1), a2 + hstepA, voffA);
            PG8_WAIT_L(8); PG8_BAR; PG8_WAIT_L(0); PG8_MMA(0, 0, At, B0); PG8_BAR; PG8_SCHED;
            PG8_LDB(B1, 1, 1); PG8_STAGE(PG8_SB(1, 0), b3, voffB);
            PG8_BAR; PG8_WAIT_L(0); PG8_MMA(0, 1, At, B1); PG8_BAR;
            PG8_LDA(At, 1, 1); PG8_STAGE(PG8_SA(1, 0), a3, voffA);
            PG8_BAR; PG8_WAIT_L(0); PG8_MMA(1, 0, At, B0); PG8_BAR; PG8_SCHED;
            PG8_STAGE(PG8_SB(1, 1), b3 + hstepB, voffB);
            PG8_WAIT_V(6); PG8_BAR; PG8_MMA(1, 1, At, B1); PG8_BAR;
        }
        if constexpr (!Epi::AFTER_DRAIN) E(acc, cur, wr, wc, fr, fq);
        if (!has_next) break;
#pragma unroll
        for (int a = 0; a < 2; ++a)
#pragma unroll
            for (int b = 0; b < 2; ++b)
#pragma unroll
                for (int m = 0; m < 4; ++m)
#pragma unroll
                    for (int n = 0; n < 2; ++n) acc[a][b][m][n] = (f32x4){0.f, 0.f, 0.f, 0.f};
        cur = nxt; cA = nA; cB = nB; ++ui;
    }
    PG8_WAIT_V(0);
    if (wr == 0) PG8_BAR;
    PG8_BAR;
    if constexpr (Epi::AFTER_DRAIN) E.fused(acc, cur, wr, wc, fr, fq, lds, wid, lane);
#undef PG8_SA
#undef PG8_SB
#undef PG8_STAGE
#undef PG8_LDA
#undef PG8_LDB
#undef PG8_MMA
#undef PG8_WAIT_V
#undef PG8_WAIT_L
#undef PG8_BAR
#undef PG8_SCHED
}

typedef f32x4 AccT[2][2][4][2];
__device__ __forceinline__ u32x4 pack8(const f32x4 a, const f32x4 b) { u32x4 w; w.x = cvt_pk_bf16(a[0], a[1]); w.y = cvt_pk_bf16(a[2], a[3]); w.z = cvt_pk_bf16(b[0], b[1]); w.w = cvt_pk_bf16(b[2], b[3]); return w; }

struct EpiWin {
    static constexpr bool PERM = true, RPERM = false, AFTER_DRAIN = false; static constexpr int AMODE = 0;
    bf16_t* A2;
    __device__ __forceinline__ void operator()(AccT& acc, const Unit& u, int wr, int wc, int fr, int fq) const {
#pragma unroll
        for (int ai = 0; ai < 2; ++ai)
#pragma unroll
            for (int m = 0; m < 4; ++m) { const int rc = u.pm * 16 + ai * 8 + wr * 4 + m;
#pragma unroll
                for (int bj = 0; bj < 2; ++bj) { const int colb = u.pn * 256 + bj * 128 + wc * 32 + 8 * fq, g = colb >> 4, c0 = colb & 15;
                    *(u32x4*)(A2 + ((size_t)(g * 1024 + rc) * 384 + fr * 16 + c0)) = pack8(acc[ai][bj][m][0], acc[ai][bj][m][1]); }
                asm volatile("" ::: "memory"); }
    }
};
struct EpiS1 {
    static constexpr bool PERM = false, RPERM = false, AFTER_DRAIN = false; static constexpr int AMODE = 0;
    float* Sl;
    __device__ __forceinline__ void operator()(AccT& acc, const Unit& u, int wr, int wc, int fr, int fq) const {
#pragma unroll
        for (int ai = 0; ai < 2; ++ai)
#pragma unroll
            for (int m = 0; m < 4; ++m) { const int row = u.pm * 256 + ai * 128 + wr * 64 + m * 16 + fr;
#pragma unroll
                for (int n = 0; n < 2; ++n) *(f32x4*)(Sl + (size_t)row * 128 + wc * 32 + n * 16 + 4 * fq) = acc[ai][0][m][n]; }
    }
};
struct EpiS2 {
    static constexpr bool PERM = true, RPERM = false, AFTER_DRAIN = false; static constexpr int AMODE = 0;
    const bf16_t* A2g; const float* dsk; bf16_t* hA; int g;
    __device__ __forceinline__ void operator()(AccT& acc, const Unit& u, int wr, int wc, int fr, int fq) const {
        const int colb = wc * 32 + 8 * fq, rcb = u.pm * 256 + wr * 64 + fr;
        f32x4 d[2][2];
#pragma unroll
        for (int bj = 0; bj < 2; ++bj) { const int c0 = (bj * 128 + colb) & 15; d[bj][0] = *(const f32x4*)(dsk + g * 16 + c0); d[bj][1] = *(const f32x4*)(dsk + g * 16 + c0 + 4); }
        u32x4 uw[2];
        uw[0] = *(const u32x4*)(A2g + (size_t)rcb * 384 + colb);
#pragma unroll
        for (int st = 0; st < 16; ++st) { const int bj = st >> 3, ai = (st >> 2) & 1, m = st & 3;
            if (st + 1 < 16) { const int nb = (st + 1) >> 3, na = ((st + 1) >> 2) & 1, nm = (st + 1) & 3; uw[(st + 1) & 1] = *(const u32x4*)(A2g + (size_t)(rcb + na * 128 + nm * 16) * 384 + nb * 128 + colb); }
            asm volatile("" ::: "memory");
            const int col = bj * 128 + colb, l = col >> 4, c0 = col & 15, rc = rcb + ai * 128 + m * 16; const u32x4 w = uw[st & 1];
            f32x4 a = acc[ai][bj][m][0], b = acc[ai][bj][m][1];
            a[0] += d[bj][0][0] * bflo(w.x); a[1] += d[bj][0][1] * bfhi(w.x); a[2] += d[bj][0][2] * bflo(w.y); a[3] += d[bj][0][3] * bfhi(w.y);
            b[0] += d[bj][1][0] * bflo(w.z); b[1] += d[bj][1][1] * bfhi(w.z); b[2] += d[bj][1][2] * bflo(w.w); b[3] += d[bj][1][3] * bfhi(w.w);
#pragma unroll
            for (int j = 0; j < 4; j += 2) { const f32x2 ga = gelu2((f32x2){a[j], a[j + 1]}), gb = gelu2((f32x2){b[j], b[j + 1]}); a[j] = ga.x; a[j + 1] = ga.y; b[j] = gb.x; b[j + 1] = gb.y; }
            u32x4 o = pack8(a, b); asm volatile("" : "+v"(o));
            *(u32x4*)(hA + ((size_t)g * MP + rc * 16 + l) * 16 + c0) = o; }
    }
};

struct EpiGlu {
    static constexpr bool PERM = false, RPERM = false, AFTER_DRAIN = false; static constexpr int AMODE = 1;
    const float* xres; const float* gmod; bf16_t* T;
    __device__ __forceinline__ void operator()(AccT& acc, const Unit& u, int wr, int wc, int fr, int fq) const {
        const int ns = u.pm >> 3, colb = u.pn * 128 + wc * 32 + 4 * fq, rowb = u.pm * 256 + wr * 64 + fr;
        f32x4 gm[2], xr[2][2];
#pragma unroll
        for (int n = 0; n < 2; ++n) { gm[n] = *(const f32x4*)(gmod + (size_t)ns * NMOD + colb + n * 16); xr[0][n] = *(const f32x4*)(xres + (size_t)rowb * 1024 + colb + n * 16); }
#pragma unroll
        for (int st = 0; st < 8; ++st) { const int ai = st >> 2, m = st & 3, row = rowb + ai * 128 + m * 16;
            if (st + 1 < 8) { const int nrow = rowb + ((st + 1) >> 2) * 128 + ((st + 1) & 3) * 16;
#pragma unroll
                for (int n = 0; n < 2; ++n) xr[(st + 1) & 1][n] = *(const f32x4*)(xres + (size_t)nrow * 1024 + colb + n * 16); }
            asm volatile("" ::: "memory");
#pragma unroll
            for (int n = 0; n < 2; ++n) { const f32x4 v = acc[ai][0][m][n], gt = acc[ai][1][m][n], x = xr[st & 1][n]; f32x4 o;
#pragma unroll
                for (int j = 0; j < 4; ++j) o[j] = ALPHA * x[j] + gm[n][j] * (v[j] * sigmoidf_(gt[j]));
                u32x2 w; w.x = cvt_pk_bf16(o[0], o[1]); w.y = cvt_pk_bf16(o[2], o[3]); asm volatile("" : "+v"(w));
                *(u32x2*)(T + (size_t)row * 1024 + colb + n * 16) = w; } }
    }
};

struct EpiT {
    static constexpr bool PERM = false, RPERM = false, AFTER_DRAIN = false; static constexpr int AMODE = 0;
    const float* xres; const float* gmod; float* T;
    __device__ __forceinline__ void operator()(AccT& acc, const Unit& u, int wr, int wc, int fr, int fq) const {
#pragma unroll
        for (int ai = 0; ai < 2; ++ai)
#pragma unroll
            for (int m = 0; m < 4; ++m) { const int row = u.pm * 256 + ai * 128 + wr * 64 + m * 16 + fr; const int ns = row >> 11;
#pragma unroll
                for (int bj = 0; bj < 2; ++bj)
#pragma unroll
                    for (int n = 0; n < 2; ++n) { const int col = u.pn * 256 + bj * 128 + wc * 32 + n * 16 + 4 * fq;
                        const f32x4 xr = *(const f32x4*)(xres + (size_t)row * 1024 + col), gm = *(const f32x4*)(gmod + (size_t)ns * NMOD + col);
                        *(f32x4*)(T + (size_t)row * 1024 + col) = ALPHA * xr + gm * acc[ai][bj][m][n]; }
                asm volatile("" ::: "memory"); }
    }
};
struct EpiGateB {
    static constexpr bool PERM = true, RPERM = false, AFTER_DRAIN = false; static constexpr int AMODE = 0;
    bf16_t* z2;
    __device__ __forceinline__ void operator()(AccT& acc, const Unit& u, int wr, int wc, int fr, int fq) const {
#pragma unroll
        for (int ai = 0; ai < 2; ++ai)
#pragma unroll
            for (int m = 0; m < 4; ++m) { const int row = u.pm * 256 + ai * 128 + wr * 64 + m * 16 + fr;
#pragma unroll
                for (int bj = 0; bj < 2; ++bj) *(u32x4*)(z2 + (size_t)row * 2048 + u.pn * 256 + bj * 128 + wc * 32 + 8 * fq) = pack8(acc[ai][bj][m][0], acc[ai][bj][m][1]);
                asm volatile("" ::: "memory"); }
    }
};
struct EpiCv {
    static constexpr bool PERM = true, RPERM = false, AFTER_DRAIN = false; static constexpr int AMODE = 0;
    bf16_t* z2;
    __device__ __forceinline__ void operator()(AccT& acc, const Unit& u, int wr, int wc, int fr, int fq) const {
#pragma unroll
        for (int ai = 0; ai < 2; ++ai)
#pragma unroll
            for (int m = 0; m < 4; ++m) { const int row = u.pm * 256 + ai * 128 + wr * 64 + m * 16 + fr;
                *(u32x4*)(z2 + (size_t)row * 2048 + 1024 + u.pn * 128 + wc * 32 + 8 * fq) = pack8(acc[ai][0][m][0] * acc[ai][1][m][0], acc[ai][0][m][1] * acc[ai][1][m][1]);
                asm volatile("" ::: "memory"); }
    }
};
struct EpiUp {
    static constexpr bool PERM = true, RPERM = true, AFTER_DRAIN = false; static constexpr int AMODE = 0;
    bf16_t* act; bf16_t* halo; float* ffn_out; const float* cw; const float* cb;
    __device__ __forceinline__ void operator()(AccT& acc, const Unit& u, int wr, int wc, int fr, int fq) const {
        const int vcol = u.pn * 128 + wc * 32 + 8 * fq, blk = u.pm * 2 + wr;
        asm volatile("" ::: "memory"); __builtin_amdgcn_sched_barrier(0);
        if (fr < 2) {
#pragma unroll
            for (int bj = 0; bj < 2; ++bj) *(u32x4*)(halo + (size_t)(blk * 4 + fr) * DFF2 + bj * DFF + vcol) = pack8(acc[0][bj][0][0], acc[0][bj][0][1]);
        }
        if (fr >= 14) {
#pragma unroll
            for (int bj = 0; bj < 2; ++bj) { *(u32x4*)(halo + (size_t)(blk * 4 + 2 + (fr - 14)) * DFF2 + bj * DFF + vcol) = pack8(acc[1][bj][3][0], acc[1][bj][3][1]);
                if ((u.pm & 7) == 7 && wr == 1) { float* o = ffn_out + (size_t)((u.pm >> 3) * 2 + (fr - 14)) * DFF2 + bj * DFF + vcol; *(f32x4*)o = acc[1][bj][3][0]; *(f32x4*)(o + 4) = acc[1][bj][3][1]; } }
        }
        asm volatile("" ::: "memory"); __builtin_amdgcn_sched_barrier(0);
        f32x4 wq[2][4];
        { const int col = vcol; wq[0][0] = *(const f32x4*)(cw + col); wq[0][1] = *(const f32x4*)(cw + DFF2 + col); wq[0][2] = *(const f32x4*)(cw + 2 * DFF2 + col); wq[0][3] = *(const f32x4*)(cb + col); }
#pragma unroll
        for (int gi = 0; gi < 4; ++gi) { const int bj = gi >> 1, n = gi & 1;
            if (gi + 1 < 4) { const int col = ((gi + 1) >> 1) * DFF + vcol + 4 * ((gi + 1) & 1);
                wq[(gi + 1) & 1][0] = *(const f32x4*)(cw + col); wq[(gi + 1) & 1][1] = *(const f32x4*)(cw + DFF2 + col); wq[(gi + 1) & 1][2] = *(const f32x4*)(cw + 2 * DFF2 + col); wq[(gi + 1) & 1][3] = *(const f32x4*)(cb + col); }
            asm volatile("" ::: "memory");
            const f32x4 w0 = wq[gi & 1][0], w1 = wq[gi & 1][1], w2 = wq[gi & 1][2], bb = wq[gi & 1][3];
            f32x4 w1c, w1p, w0c, w0p;
#pragma unroll
            for (int j = 0; j < 4; ++j) { w1c[j] = (fr == 0) ? 0.f : w1[j]; w1p[j] = (fr == 0) ? w1[j] : 0.f; w0c[j] = (fr < 2) ? 0.f : w0[j]; w0p[j] = (fr < 2) ? w0[j] : 0.f; }
#pragma unroll
            for (int rg = 7; rg >= 0; --rg) { const int ai = rg >> 2, m = rg & 3, pi = (rg ? rg - 1 : 0) >> 2, pmm = (rg ? rg - 1 : 0) & 3;
                const f32x4 cur = acc[ai][bj][m][n], prev = acc[pi][bj][pmm][n]; f32x4 r;
#pragma unroll
                for (int j = 0; j < 4; ++j) { float t = w2[j] * cur[j] + bb[j];
                    asm volatile("s_nop 1\n\tv_fmac_f32_dpp %0, %1, %2 row_ror:1 row_mask:0xf bank_mask:0xf" : "+v"(t) : "v"(cur[j]), "v"(w1c[j]));
                    asm volatile("v_fmac_f32_dpp %0, %1, %2 row_ror:1 row_mask:0xf bank_mask:0xf" : "+v"(t) : "v"(prev[j]), "v"(w1p[j]));
                    asm volatile("v_fmac_f32_dpp %0, %1, %2 row_ror:2 row_mask:0xf bank_mask:0xf" : "+v"(t) : "v"(cur[j]), "v"(w0c[j]));
                    asm volatile("v_fmac_f32_dpp %0, %1, %2 row_ror:2 row_mask:0xf bank_mask:0xf" : "+v"(t) : "v"(prev[j]), "v"(w0p[j]));
                    r[j] = t; }
                acc[ai][bj][m][n] = r; } }
#pragma unroll
        for (int rg = 0; rg < 8; ++rg) { const int ai = rg >> 2, m = rg & 3; const int row = u.pm * 256 + wr * 128 + rg * 16 + fr;
            f32x4 a, b;
#pragma unroll
            for (int j = 0; j < 4; j += 2) { const f32x2 ga = gelu2((f32x2){acc[ai][1][m][0][j], acc[ai][1][m][0][j + 1]}), gb = gelu2((f32x2){acc[ai][1][m][1][j], acc[ai][1][m][1][j + 1]});
                a[j] = ga.x * acc[ai][0][m][0][j]; a[j + 1] = ga.y * acc[ai][0][m][0][j + 1]; b[j] = gb.x * acc[ai][0][m][1][j]; b[j + 1] = gb.y * acc[ai][0][m][1][j + 1]; }
            if (rg != 0 || fr >= 2) *(u32x4*)(act + (size_t)row * DFF + vcol) = pack8(a, b);
            asm volatile("" ::: "memory"); __builtin_amdgcn_sched_barrier(0); }
    }
};

template <int XIN, bool XOUT_F32> struct EpiLnT {
    static constexpr bool XREC = (XIN == 1); const bf16_t* xbi; bf16_t* xbo;
    static constexpr bool PERM = false, RPERM = false, AFTER_DRAIN = true; static constexpr int AMODE = 0;
    const bf16_t* Tb; const float* stats; const float* lg0; const float* lb0;
    const float* xres; const float* mods; int gate_off, next_off; const float* lg; const float* lb; float* xout; bf16_t* hA; unsigned long long* xbuf; unsigned* cnt;
    __device__ __forceinline__ void fused(AccT& acc, const Unit& u, int wr, int wc, int fr, int fq, LAS unsigned char* lds, int wid, int lane) const {
        typedef float f32x2v __attribute__((ext_vector_type(2)));
        const int ns = u.pm >> 3, tid = wid * 64 + lane;
        LAS f32x2v* Pt = (LAS f32x2v*)lds;
        LAS f32x2v* St = (LAS f32x2v*)(lds + 8192);
        if constexpr (XIN == 0) {
            const int colb = u.pn * 256 + wc * 32 + 4 * fq, rowb = u.pm * 256 + wr * 64 + fr;
            f32x4 gm[2][2], xr[2][2][2];
#pragma unroll
            for (int bj = 0; bj < 2; ++bj)
#pragma unroll
                for (int n = 0; n < 2; ++n) { gm[bj][n] = *(const f32x4*)(mods + (size_t)ns * NMOD + gate_off + colb + bj * 128 + n * 16); xr[0][bj][n] = *(const f32x4*)(xres + (size_t)rowb * 1024 + colb + bj * 128 + n * 16); }
#pragma unroll
            for (int st = 0; st < 8; ++st) { const int ai = st >> 2, m = st & 3;
                if (st + 1 < 8) { const int nrow = rowb + ((st + 1) >> 2) * 128 + ((st + 1) & 3) * 16;
#pragma unroll
                    for (int bj = 0; bj < 2; ++bj)
#pragma unroll
                        for (int n = 0; n < 2; ++n) xr[(st + 1) & 1][bj][n] = *(const f32x4*)(xres + (size_t)nrow * 1024 + colb + bj * 128 + n * 16); }
                asm volatile("" ::: "memory");
#pragma unroll
                for (int bj = 0; bj < 2; ++bj)
#pragma unroll
                    for (int n = 0; n < 2; ++n) acc[ai][bj][m][n] = ALPHA * xr[st & 1][bj][n] + gm[bj][n] * acc[ai][bj][m][n];
                asm volatile("" : "+v"(acc[ai][0][m][0]), "+v"(acc[ai][0][m][1]), "+v"(acc[ai][1][m][0]), "+v"(acc[ai][1][m][1])); }
        } else if constexpr (XIN == 2) {
            const int colb = u.pn * 256 + wc * 32 + 4 * fq, rowb = u.pm * 256 + wr * 64 + fr;
            f32x4 gm[2][2]; u32x2 xr[2][2][2];
#pragma unroll
            for (int bj = 0; bj < 2; ++bj)
#pragma unroll
                for (int n = 0; n < 2; ++n) { gm[bj][n] = *(const f32x4*)(mods + (size_t)ns * NMOD + gate_off + colb + bj * 128 + n * 16); xr[0][bj][n] = *(const u32x2*)(xbi + (size_t)rowb * 1024 + colb + bj * 128 + n * 16); }
#pragma unroll
            for (int st = 0; st < 8; ++st) { const int ai = st >> 2, m = st & 3;
                if (st + 1 < 8) { const int nrow = rowb + ((st + 1) >> 2) * 128 + ((st + 1) & 3) * 16;
#pragma unroll
                    for (int bj = 0; bj < 2; ++bj)
#pragma unroll
                        for (int n = 0; n < 2; ++n) xr[(st + 1) & 1][bj][n] = *(const u32x2*)(xbi + (size_t)nrow * 1024 + colb + bj * 128 + n * 16); }
                asm volatile("" ::: "memory");
#pragma unroll
                for (int bj = 0; bj < 2; ++bj)
#pragma unroll
                    for (int n = 0; n < 2; ++n) { const u32x2 w = xr[st & 1][bj][n]; acc[ai][bj][m][n] = ALPHA * (f32x4){bflo(w.x), bfhi(w.x), bflo(w.y), bfhi(w.y)} + gm[bj][n] * acc[ai][bj][m][n]; }
                asm volatile("" : "+v"(acc[ai][0][m][0]), "+v"(acc[ai][0][m][1]), "+v"(acc[ai][1][m][0]), "+v"(acc[ai][1][m][1])); }
        } else {
            const int colb = u.pn * 256 + wc * 32 + 4 * fq, rowb = u.pm * 256 + wr * 64 + fr;
            f32x4 gm[2][2], g0[2][2], b0[2][2]; u32x2 tb[2][2][2]; f32x2v sr[2];
#pragma unroll
            for (int bj = 0; bj < 2; ++bj)
#pragma unroll
                for (int n = 0; n < 2; ++n) { const int col = colb + bj * 128 + n * 16; gm[bj][n] = *(const f32x4*)(mods + (size_t)ns * NMOD + gate_off + col);
                    g0[bj][n] = *(const f32x4*)(lg0 + col); b0[bj][n] = *(const f32x4*)(lb0 + col); tb[0][bj][n] = *(const u32x2*)(Tb + (size_t)rowb * 1024 + col); }
            sr[0] = *(const f32x2v*)(stats + (size_t)rowb * 2);
#pragma unroll
            for (int st = 0; st < 8; ++st) { const int ai = st >> 2, m = st & 3;
                if (st + 1 < 8) { const int nrow = rowb + ((st + 1) >> 2) * 128 + ((st + 1) & 3) * 16; sr[(st + 1) & 1] = *(const f32x2v*)(stats + (size_t)nrow * 2);
#pragma unroll
                    for (int bj = 0; bj < 2; ++bj)
#pragma unroll
                        for (int n = 0; n < 2; ++n) tb[(st + 1) & 1][bj][n] = *(const u32x2*)(Tb + (size_t)nrow * 1024 + colb + bj * 128 + n * 16); }
                asm volatile("" ::: "memory");
                const float mean = sr[st & 1].x, rstd = sr[st & 1].y;
#pragma unroll
                for (int bj = 0; bj < 2; ++bj)
#pragma unroll
                    for (int n = 0; n < 2; ++n) { const u32x2 w = tb[st & 1][bj][n]; const f32x4 t = (f32x4){bflo(w.x), bfhi(w.x), bflo(w.y), bfhi(w.y)};
                        const f32x4 x = (t - mean) * rstd * g0[bj][n] + b0[bj][n];
                        acc[ai][bj][m][n] = ALPHA * x + gm[bj][n] * acc[ai][bj][m][n]; }
                asm volatile("" : "+v"(acc[ai][0][m][0]), "+v"(acc[ai][0][m][1]), "+v"(acc[ai][1][m][0]), "+v"(acc[ai][1][m][1])); }
        }
#pragma unroll
        for (int ai = 0; ai < 2; ++ai)
#pragma unroll
            for (int m = 0; m < 4; ++m) { float s_ = 0.f, q_ = 0.f;
#pragma unroll
                for (int bj = 0; bj < 2; ++bj)
#pragma unroll
                    for (int n = 0; n < 2; ++n) { const f32x4 x = acc[ai][bj][m][n]; s_ += (x[0] + x[1]) + (x[2] + x[3]); q_ += (x[0] * x[0] + x[1] * x[1]) + (x[2] * x[2] + x[3] * x[3]); }
                s_ += __shfl_xor(s_, 16); s_ += __shfl_xor(s_, 32); q_ += __shfl_xor(q_, 16); q_ += __shfl_xor(q_, 32);
                if (fq == 0) Pt[(ai * 128 + wr * 64 + m * 16 + fr) * 4 + wc] = (f32x2v){s_, q_}; }
        __syncthreads();
        if (tid < 256) { const f32x2v a = Pt[tid * 4 + 0], b = Pt[tid * 4 + 1], c = Pt[tid * 4 + 2], d = Pt[tid * 4 + 3];
            const float S = (a.x + b.x) + (c.x + d.x), Q = (a.y + b.y) + (c.y + d.y);
            __hip_atomic_store(xbuf + ((size_t)(u.pm * 256 + tid) * 4 + u.pn), ((unsigned long long)__float_as_uint(Q) << 32) | __float_as_uint(S), __ATOMIC_RELAXED, __HIP_MEMORY_SCOPE_AGENT); }
        asm volatile("s_waitcnt vmcnt(0)" ::: "memory");
        if (tid < 256 && lane == 0) __hip_atomic_fetch_add(cnt + 16 * u.pm, 1u, __ATOMIC_RELAXED, __HIP_MEMORY_SCOPE_AGENT);
        if (wid == 0) { unsigned spins = 0;
            while ((unsigned)__builtin_amdgcn_readfirstlane(__hip_atomic_load(cnt + 16 * u.pm, __ATOMIC_RELAXED, __HIP_MEMORY_SCOPE_AGENT)) < 16u) { __builtin_amdgcn_s_sleep(1); if (++spins > (1u << 22)) break; }
            __builtin_amdgcn_fence(__ATOMIC_ACQUIRE, "agent"); asm volatile("s_waitcnt vmcnt(0)" ::: "memory"); }
        __syncthreads();
        if (tid < 256) { const unsigned long long* sl = xbuf + (size_t)(u.pm * 256 + tid) * 4; float S = 0.f, Q = 0.f;
#pragma unroll
            for (int t = 0; t < 4; ++t) { const unsigned long long w = __hip_atomic_load(sl + t, __ATOMIC_RELAXED, __HIP_MEMORY_SCOPE_AGENT); S += __uint_as_float((unsigned)w); Q += __uint_as_float((unsigned)(w >> 32)); }
            const float mean = S * (1.0f / 1024.0f), var = fmaxf(Q * (1.0f / 1024.0f) - mean * mean, 0.f);
            St[tid] = (f32x2v){mean, 1.0f / sqrtf(var + LN_EPS)}; }
        __syncthreads();
#pragma unroll
        for (int bj = 0; bj < 2; ++bj)
#pragma unroll
            for (int n = 0; n < 2; ++n) { const int col = u.pn * 256 + bj * 128 + wc * 32 + n * 16 + 4 * fq;
                const f32x4 gg = *(const f32x4*)(lg + col), bb = *(const f32x4*)(lb + col);
                f32x4 sh = (f32x4){0.f, 0.f, 0.f, 0.f}, sc = sh;
                if (next_off >= 0) { sh = *(const f32x4*)(mods + (size_t)ns * NMOD + next_off + col); sc = *(const f32x4*)(mods + (size_t)ns * NMOD + next_off + 1024 + col); }
#pragma unroll
                for (int ai = 0; ai < 2; ++ai)
#pragma unroll
                    for (int m = 0; m < 4; ++m) { const int rl = ai * 128 + wr * 64 + m * 16 + fr; const f32x2v st = St[rl]; const size_t off = (size_t)(u.pm * 256 + rl) * 1024 + col;
                        const f32x4 xn = (acc[ai][bj][m][n] - st.x) * st.y * gg + bb;
                        if constexpr (XOUT_F32) *(f32x4*)(xout + off) = xn; else { u32x2 xw; xw.x = cvt_pk_bf16(xn[0], xn[1]); xw.y = cvt_pk_bf16(xn[2], xn[3]); *(u32x2*)(xbo + off) = xw; }
                        if (next_off >= 0) { u32x2 w; w.x = cvt_pk_bf16(xn[0] * (1.f + sc[0]) + sh[0], xn[1] * (1.f + sc[1]) + sh[1]); w.y = cvt_pk_bf16(xn[2] * (1.f + sc[2]) + sh[2], xn[3] * (1.f + sc[3]) + sh[3]);
                            *(u32x2*)(hA + off) = w; } }
                asm volatile("" ::: "memory"); }
    }
};

template <int STEPS>
__device__ __forceinline__ void skinny_gemm(const bf16_t* A, int K, int nrb, int rows_valid, const bf16_t* Bt, int N, float* out, const float* bias, int ustart, int ustride) {
    const int tid = ltid(), wid = tid >> 6, lane = tid & 63, fr = lane & 15, fq = lane >> 4;
    const int KS = K / (32 * STEPS), ncb = N / 16, nunits = ncb * KS;
    for (int skr_ = 0; skr_ < SKREP; ++skr_)
    for (int u = ustart; u < nunits; u += ustride) {
        const int cb = u % ncb, ks = u / ncb, col0 = cb * 16, k0 = ks * 32 * STEPS;
        for (int rb = wid; rb < nrb; rb += 8) {
            const bf16_t* ap = A + (size_t)(rb * 16 + fr) * K + k0 + fq * 8; const bf16_t* bp = Bt + (size_t)(col0 + fr) * K + k0 + fq * 8;
            bf16x8 a[STEPS], b[STEPS];
#pragma unroll
            for (int i = 0; i < STEPS; ++i) { a[i] = *(const bf16x8*)(ap + 32 * i); b[i] = *(const bf16x8*)(bp + 32 * i); }
            f32x4 acc = (f32x4){0.f, 0.f, 0.f, 0.f};
#pragma unroll
            for (int i = 0; i < STEPS; ++i) acc = __builtin_amdgcn_mfma_f32_16x16x32_bf16(b[i], a[i], acc, 0, 0, 0);
            const int row = rb * 16 + fr;
            if (row < rows_valid) { const int c = col0 + fq * 4; if (bias) acc += *(const f32x4*)(bias + c);
                *(f32x4*)(out + ((size_t)ks * rows_valid + row) * N + c) = acc; }
        }
    }
}
__device__ __forceinline__ f32x4 rawsum4(const float* raw, size_t idx, int KS, size_t stride) { f32x4 v = *(const f32x4*)(raw + idx); for (int k = 1; k < KS; ++k) v += *(const f32x4*)(raw + k * stride + idx); return v; }
__device__ __forceinline__ float rawsum1(const float* raw, size_t idx, int KS, size_t stride) { float v = raw[idx]; for (int k = 1; k < KS; ++k) v += raw[k * stride + idx]; return v; }
__device__ __forceinline__ void skinny3(LAS float* sm, const bf16_t* A, int K, const bf16_t* Bt, int N, float* out, int ustart, int ustride) {
    const int tid = ltid(), wid = __builtin_amdgcn_readfirstlane(tid >> 6), lane = tid & 63, fr = lane & 15, fq = lane >> 4;
    const int nsteps = K / 256, ncb = N / 16;
    const unsigned loff = (unsigned)(fr * K + fq * 8);
    for (int skr_ = 0; skr_ < SKREP; ++skr_)
    for (int u = ustart; u < ncb; u += ustride) {
        const int col0 = u * 16;
        f32x4 acc[8];
#pragma unroll
        for (int rb = 0; rb < 8; ++rb) acc[rb] = (f32x4){0.f, 0.f, 0.f, 0.f};
        for (int s0 = 0; s0 < nsteps; s0 += 4) {
            const int cnt = nsteps - s0; const size_t ku = (size_t)(wid * nsteps + s0) * 32;
            const bf16_t* bu = Bt + (size_t)col0 * K + ku; const bf16_t* au = A + ku;
            bf16x8 b[4], a[8][4];
#pragma unroll
            for (int i = 0; i < 4; ++i) { const int ii = (i < cnt) ? i : 0; b[i] = *(const bf16x8*)(bu + 32 * ii + loff); }
#pragma unroll
            for (int rb = 0; rb < 8; ++rb)
#pragma unroll
                for (int i = 0; i < 4; ++i) { const int ii = (i < cnt) ? i : 0; a[rb][i] = *(const bf16x8*)(au + (size_t)rb * 16 * K + 32 * ii + loff); }
#pragma unroll
            for (int i = 0; i < 4; ++i) if (i >= cnt) b[i] = (bf16x8){0, 0, 0, 0, 0, 0, 0, 0};
#pragma unroll
            for (int rb = 0; rb < 8; ++rb)
#pragma unroll
                for (int i = 0; i < 4; ++i) acc[rb] = __builtin_amdgcn_mfma_f32_16x16x32_bf16(b[i], a[rb][i], acc[rb], 0, 0, 0);
        }
        __syncthreads();
#pragma unroll
        for (int rb = 0; rb < 8; ++rb) *(LAS f32x4*)(sm + ((wid * 8 + rb) * 16 + fr) * 16 + fq * 4) = acc[rb];
        __syncthreads();
        { const int row = tid >> 2, cq = tid & 3; f32x4 sum = (f32x4){0.f, 0.f, 0.f, 0.f};
#pragma unroll
            for (int w = 0; w < 8; ++w) sum += *(const LAS f32x4*)(sm + ((w * 8 + (row >> 4)) * 16 + (row & 15)) * 16 + cq * 4);
            *(f32x4*)(out + (size_t)row * N + col0 + cq * 4) = sum; }
    }
}
__device__ __forceinline__ void skinny_up(KP& P, int layer, LAS float* sm, const bf16_t* A, const bf16_t* Bt, int ustart, int ustride) {
    const int tid = ltid(), wid = __builtin_amdgcn_readfirstlane(tid >> 6), lane = tid & 63, fr = lane & 15, fq = lane >> 4;
    constexpr int K = 1024; const unsigned loff = (unsigned)(fr * K + fq * 8);
    const float* cw = P.ffn_conv_w + (size_t)layer * 3 * DFF2; const float* cb = P.ffn_conv_b + (size_t)layer * DFF2; bf16_t* act = (bf16_t*)(P.ws + WS_BIG);
    for (int u = ustart; u < DFF / 16; u += ustride) {
        const int c0 = u * 16, rv = pcol(c0); const size_t ku = (size_t)wid * 128;
        bf16x8 a[8][4], b[4]; f32x4 accv[8], accg[8];
#pragma unroll
        for (int rb = 0; rb < 8; ++rb)
#pragma unroll
            for (int i = 0; i < 4; ++i) a[rb][i] = *(const bf16x8*)(A + ku + (size_t)rb * 16 * K + 32 * i + loff);
#pragma unroll
        for (int i = 0; i < 4; ++i) b[i] = *(const bf16x8*)(Bt + (size_t)rv * K + ku + 32 * i + loff);
#pragma unroll
        for (int rb = 0; rb < 8; ++rb) { accv[rb] = (f32x4){0.f, 0.f, 0.f, 0.f};
#pragma unroll
            for (int i = 0; i < 4; ++i) accv[rb] = __builtin_amdgcn_mfma_f32_16x16x32_bf16(b[i], a[rb][i], accv[rb], 0, 0, 0); }
#pragma unroll
        for (int i = 0; i < 4; ++i) b[i] = *(const bf16x8*)(Bt + (size_t)(rv + 128) * K + ku + 32 * i + loff);
#pragma unroll
        for (int rb = 0; rb < 8; ++rb) { accg[rb] = (f32x4){0.f, 0.f, 0.f, 0.f};
#pragma unroll
            for (int i = 0; i < 4; ++i) accg[rb] = __builtin_amdgcn_mfma_f32_16x16x32_bf16(b[i], a[rb][i], accg[rb], 0, 0, 0); }
        __syncthreads();
#pragma unroll
        for (int rb = 0; rb < 8; ++rb) { *(LAS f32x4*)(sm + ((wid * 8 + rb) * 16 + fr) * 16 + fq * 4) = accv[rb]; *(LAS f32x4*)(sm + 16384 + ((wid * 8 + rb) * 16 + fr) * 16 + fq * 4) = accg[rb]; }
        __syncthreads();
        { const int row = tid >> 2, cq = tid & 3, c = c0 + cq * 4; f32x4 uv = (f32x4){0.f, 0.f, 0.f, 0.f}, ug = uv;
#pragma unroll
            for (int w = 0; w < 8; ++w) { uv += *(const LAS f32x4*)(sm + ((w * 8 + (row >> 4)) * 16 + (row & 15)) * 16 + cq * 4); ug += *(const LAS f32x4*)(sm + 16384 + ((w * 8 + (row >> 4)) * 16 + (row & 15)) * 16 + cq * 4); }
            const float* st = P.st_ffn + (size_t)(layer * NS + row) * 2 * DFF2; float* so = P.out + O_FFN_S + (size_t)(layer * NS + row) * 2 * DFF2;
            const f32x4 b0v = *(const f32x4*)(st + c), b1v = *(const f32x4*)(st + DFF2 + c), b0g = *(const f32x4*)(st + DFF + c), b1g = *(const f32x4*)(st + DFF2 + DFF + c);
            const f32x4 cv = *(const f32x4*)(cw + 2 * DFF2 + c) * uv + *(const f32x4*)(cw + DFF2 + c) * b1v + *(const f32x4*)(cw + c) * b0v + *(const f32x4*)(cb + c);
            const f32x4 cg_ = *(const f32x4*)(cw + 2 * DFF2 + DFF + c) * ug + *(const f32x4*)(cw + DFF2 + DFF + c) * b1g + *(const f32x4*)(cw + DFF + c) * b0g + *(const f32x4*)(cb + DFF + c);
            *(f32x4*)(so + c) = b1v; *(f32x4*)(so + DFF2 + c) = uv; *(f32x4*)(so + DFF + c) = b1g; *(f32x4*)(so + DFF2 + DFF + c) = ug;
            u32x2 w; w.x = cvt_pk_bf16(gelu_tanh(cg_[0]) * cv[0], gelu_tanh(cg_[1]) * cv[1]); w.y = cvt_pk_bf16(gelu_tanh(cg_[2]) * cv[2], gelu_tanh(cg_[3]) * cv[3]);
            *(u32x2*)(act + (size_t)(MP + row) * DFF + c) = w; }
    }
    __syncthreads();
}

struct TrD { const float* W; bf16_t* Bt; int K, Nsrc, mode, half, rb, kb; };
__device__ __forceinline__ bool tr_decode(KP& P, int it, TrD& d) {
    if (it < 0 || it >= 1504) return false;
    unsigned char* ws = P.ws; int i = it;
    if (i < 64) { d = TrD{P.s5_w_in, (bf16_t*)(ws + WS_WIN), 1024, 1024, 0, 0, i / 16, i % 16}; return true; } i -= 64;
    if (i < 128) { d = TrD{P.w_glu, (bf16_t*)(ws + WS_WGLU), 1024, 2048, 1, 1024, i / 16, i % 16}; return true; } i -= 128;
    if (i < 192) { d = TrD{P.sc_w_in, (bf16_t*)(ws + WS_SCIN), 1024, 3072, 2, 0, i / 16, i % 16}; return true; } i -= 192;
    if (i < 64) { d = TrD{P.sc_w_out, (bf16_t*)(ws + WS_SCOUT), 1024, 1024, 0, 0, i / 16, i % 16}; return true; } i -= 64;
    if (i < 704) { const int l = i / 352, j = i % 352; d = TrD{P.ffn_w_up + (size_t)l * 1024 * DFF2, (bf16_t*)(ws + WS_UP) + (size_t)l * DFF2 * 1024, 1024, DFF2, 1, DFF, j / 16, j % 16}; return true; } i -= 704;
    { const int l = i / 176, j = i % 176; d = TrD{P.ffn_w_down + (size_t)l * DFF * 1024, (bf16_t*)(ws + WS_DOWN) + (size_t)l * 1024 * DFF, DFF, 1024, 0, 0, j / 44, j % 44}; return true; }
}
__device__ __forceinline__ void tr_load(const TrD& d, int tid, f32x4 (&r)[8]) {
#pragma unroll
    for (int i = 0; i < 8; ++i) { const int idx4 = tid + NTHR * i, kr = idx4 >> 6, nc4 = (idx4 & 63) * 4, sb = nc4 >> 6, within = sb * 64;
        int src0;
        if (d.mode == 0) src0 = d.rb * 256 + within;
        else if (d.mode == 1) src0 = (within < 128) ? 128 * d.rb + within : d.half + 128 * d.rb + within - 128;
        else { if (d.rb < 4) src0 = d.rb * 256 + within; else { const int t = d.rb - 4; src0 = (within < 128) ? 1024 + 128 * t + within : 2048 + 128 * t + within - 128; } }
        r[i] = *(const f32x4*)(d.W + (size_t)(d.kb * 64 + kr) * d.Nsrc + src0 + (nc4 & 63)); }
}
__device__ __forceinline__ void tr_store(LAS float* sm, const TrD& d, int tid, const f32x4 (&r)[8]) {
    __syncthreads();
#pragma unroll
    for (int i = 0; i < 8; ++i) { const int idx4 = tid + NTHR * i, kr = idx4 >> 6, nc4 = (idx4 & 63) * 4; LAS float* q = sm + kr * 257 + nc4; q[0] = r[i][0]; q[1] = r[i][1]; q[2] = r[i][2]; q[3] = r[i][3]; }
    __syncthreads();
#pragma unroll
    for (int i = 0; i < 4; ++i) { const int np = (tid >> 3) + 64 * i, kp = tid & 7; float e[8];
#pragma unroll
        for (int q = 0; q < 8; ++q) e[q] = sm[(kp * 8 + q) * 257 + np];
        u32x4 w; w.x = cvt_pk_bf16(e[0], e[1]); w.y = cvt_pk_bf16(e[2], e[3]); w.z = cvt_pk_bf16(e[4], e[5]); w.w = cvt_pk_bf16(e[6], e[7]);
        *(u32x4*)(d.Bt + (size_t)(d.rb * 256 + np) * d.K + d.kb * 64 + kp * 8) = w; }
}
__device__ __forceinline__ int p0_item(int bx, int G, int k) {
    if (G != 256) return bx + G * k;
    return bx < 64 ? (k < 7 ? bx + 64 * k : -1) : 448 + (bx - 64) + 192 * k;
}
__device__ __forceinline__ void p0_convert(KP& P, LAS float* sm) {
    unsigned char* ws = P.ws; const int G = gridDim.x, bx = blockIdx.x, tid = ltid();
    int k = 0; TrD d, dn; f32x4 r[8], rn[8];
    bool v = tr_decode(P, p0_item(bx, G, 0), d);
    if (v) tr_load(d, tid, r);
    while (v) {
        ++k; const bool vn = tr_decode(P, p0_item(bx, G, k), dn);
        if (vn) tr_load(dn, tid, rn);
        tr_store(sm, d, tid, r);
        d = dn; v = vn;
#pragma unroll
        for (int i = 0; i < 8; ++i) r[i] = rn[i];
    }
}
__device__ __forceinline__ void mods_phase(KP& P, LAS float* sm, int ustart, int ustride) {
    const int tid = ltid(), wid = __builtin_amdgcn_readfirstlane(tid >> 6), lane = tid & 63, fr = lane & 15, fq = lane >> 4;
    float* mods = (float*)(P.ws + WS_MODS);
    const int ct = wid & 3, rb0 = wid >> 2; constexpr int PITCH = 65, BUF = 128 * PITCH, APITCH = 136;
    LAS bf16_t* sA = (LAS bf16_t*)(sm + 2 * BUF);
    auto ldc = [&](int ch, f32x4 (&cv)[9]) {
#pragma unroll
        for (int i = 0; i < 9; ++i) { const int e = tid + NTHR * i, row = e >> 5, k = ch * 128 + (e & 31) * 4;
            cv[i] = (f32x4){0.f, 0.f, 0.f, 0.f};
            if (row < 8) cv[i] = *(const f32x4*)(P.c_p + (size_t)row * 1024 + k); else if (row < 136) cv[i] = *(const f32x4*)(P.c_s + (size_t)(row - 8) * 1024 + k); } };
    for (int u = ustart; u < NMOD / 64; u += ustride) {
        const int j0 = u * 64; f32x4 acc[5], r[4], rn[4], cv[9], cn[9];
#pragma unroll
        for (int i = 0; i < 5; ++i) acc[i] = (f32x4){0.f, 0.f, 0.f, 0.f};
#pragma unroll
        for (int i = 0; i < 4; ++i) { const int idx = tid + NTHR * i, kr = idx >> 4, c4 = (idx & 15) * 4; r[i] = *(const f32x4*)(P.w_ada + (size_t)kr * NMOD + j0 + c4); }
        ldc(0, cv);
        for (int ch = 0; ch < 8; ++ch) {
            if (ch + 1 < 8) {
#pragma unroll
                for (int i = 0; i < 4; ++i) { const int idx = tid + NTHR * i, kr = idx >> 4, c4 = (idx & 15) * 4; rn[i] = *(const f32x4*)(P.w_ada + (size_t)((ch + 1) * 128 + kr) * NMOD + j0 + c4); }
                ldc(ch + 1, cn);
            }
            __syncthreads();
            LAS float* buf = sm + (ch & 1) * BUF;
#pragma unroll
            for (int i = 0; i < 4; ++i) { const int idx = tid + NTHR * i, kr = idx >> 4, c4 = (idx & 15) * 4; LAS float* q = buf + kr * PITCH + c4; q[0] = r[i][0]; q[1] = r[i][1]; q[2] = r[i][2]; q[3] = r[i][3]; }
#pragma unroll
            for (int i = 0; i < 9; ++i) { const int e = tid + NTHR * i, row = e >> 5, k4 = (e & 31) * 4; const f32x4 c = cv[i]; u32x2 w;
                w.x = cvt_pk_bf16(c[0] * sigmoidf_(c[0]), c[1] * sigmoidf_(c[1])); w.y = cvt_pk_bf16(c[2] * sigmoidf_(c[2]), c[3] * sigmoidf_(c[3]));
                *(LAS u32x2*)(sA + row * APITCH + k4) = w; }
            __syncthreads();
#pragma unroll
            for (int s_ = 0; s_ < 4; ++s_) { float w[8]; bf16x8 a[5];
#pragma unroll
                for (int i = 0; i < 5; ++i) { const int rb = (rb0 + 2 * i < 9) ? rb0 + 2 * i : rb0; a[i] = *(const LAS bf16x8*)(sA + (rb * 16 + fr) * APITCH + s_ * 32 + fq * 8); }
#pragma unroll
                for (int e = 0; e < 8; ++e) w[e] = buf[(s_ * 32 + fq * 8 + e) * PITCH + ct * 16 + fr];
                u32x4 pk; pk.x = cvt_pk_bf16(w[0], w[1]); pk.y = cvt_pk_bf16(w[2], w[3]); pk.z = cvt_pk_bf16(w[4], w[5]); pk.w = cvt_pk_bf16(w[6], w[7]);
                const bf16x8 bfr = __builtin_bit_cast(bf16x8, pk);
#pragma unroll
                for (int i = 0; i < 5; ++i) acc[i] = __builtin_amdgcn_mfma_f32_16x16x32_bf16(bfr, a[i], acc[i], 0, 0, 0); }
#pragma unroll
            for (int i = 0; i < 4; ++i) r[i] = rn[i];
#pragma unroll
            for (int i = 0; i < 9; ++i) cv[i] = cn[i];
        }
        const int col = j0 + ct * 16 + fq * 4; const f32x4 bias = *(const f32x4*)(P.b_ada + col);
#pragma unroll
        for (int i = 0; i < 5; ++i) { const int rb = rb0 + 2 * i, row = rb * 16 + fr; if (rb < 9 && row < 136) *(f32x4*)(mods + (size_t)row * NMOD + col) = acc[i] + bias; }
    }
    __syncthreads();
}
__device__ __forceinline__ void p0_s5_tables(KP& P, LAS float* sm) {
    LAS float* apr = sm; LAS float* api = apr + 17 * 64; LAS float* Br = api + 17 * 64; LAS float* Bi = Br + 1024; LAS float* Cr = Bi + 1024; LAS float* Ci = Cr + 1024; LAS float* Kt = Ci + 1024;
    const int tid = ltid(), G = gridDim.x;
    bf16_t* T1 = (bf16_t*)(P.ws + WS_BIG + BIG_TAB1); bf16_t* T2 = (bf16_t*)(P.ws + WS_BIG + BIG_TAB2);
    for (int g = (int)blockIdx.x; g < 64; g += G) {
        __syncthreads();
        for (int t = tid; t < 17 * 64; t += NTHR) { const int p = t & 63, e = t >> 6; double ar, ai; apow_d(P, g, p, (double)e, ar, ai); apr[e * 64 + p] = (float)ar; api[e * 64 + p] = (float)ai; }
        for (int t = tid; t < 1024; t += NTHR) { const int p = t >> 4, c = t & 15; double cr, ci; bcoef_d(P, g, p, cr, ci);
            const double br = (double)P.b_re[(g * 64 + p) * 16 + c], bi = (double)P.b_im[(g * 64 + p) * 16 + c];
            const float fr_ = (float)(cr * br - ci * bi), fi_ = (float)(cr * bi + ci * br);
            Br[p * 16 + c] = fr_; Bi[p * 16 + c] = fi_;
            float* bb = (float*)(P.ws + WS_BBAR) + ((size_t)(g * 64 + p) * 16 + c) * 2; bb[0] = fr_; bb[1] = fi_; }
        if (tid < 64) { float* sc = (float*)(P.ws + WS_S5C) + (size_t)(g * 64 + tid) * 8; double ar, ai;
            apow_d(P, g, tid, 1.0, ar, ai); sc[0] = (float)ar; sc[1] = (float)ai;
            apow_d(P, g, tid, 16.0, ar, ai); sc[2] = (float)ar; sc[3] = (float)ai;
            apow_d(P, g, tid, 512.0, ar, ai); sc[4] = (float)ar; sc[5] = (float)ai; sc[6] = 0.f; sc[7] = 0.f; }
        for (int t = tid; t < 1024; t += NTHR) { Cr[t] = P.c_re[g * 1024 + t]; Ci[t] = P.c_im[g * 1024 + t]; }
        __syncthreads();
        for (int idx = tid; idx < 4096; idx += NTHR) { const int e = idx >> 8, c = (idx >> 4) & 15, cp = idx & 15; float s = 0.f;
            for (int p = 0; p < 64; ++p) { const float ar = apr[e * 64 + p], ai = api[e * 64 + p], br = Br[p * 16 + cp], bi = Bi[p * 16 + cp];
                const float xr = ar * br - ai * bi, xi = ar * bi + ai * br; s += Cr[c * 64 + p] * xr - Ci[c * 64 + p] * xi; }
            Kt[idx] = s; }
        __syncthreads();
        for (int it = tid; it < 256 * 48; it += NTHR) { const int row = it / 48, kg = it % 48, l = row >> 4, c = row & 15; float v[8];
            if (kg < 32) { const int j = kg >> 1, c0 = (kg & 1) * 8;
#pragma unroll
                for (int i = 0; i < 8; ++i) v[i] = (j <= l) ? Kt[(l - j) * 256 + c * 16 + c0 + i] : 0.f;
            } else { const int q0 = (kg - 32) * 8;
#pragma unroll
                for (int i = 0; i < 8; ++i) { const int q = q0 + i, p = q & 63; const float cr = Cr[c * 64 + p], ci = Ci[c * 64 + p], ar = apr[(l + 1) * 64 + p], ai = api[(l + 1) * 64 + p];
                    v[i] = (q < 64) ? (cr * ar - ci * ai) : -(cr * ai + ci * ar); } }
            u32x4 w; w.x = cvt_pk_bf16(v[0], v[1]); w.y = cvt_pk_bf16(v[2], v[3]); w.z = cvt_pk_bf16(v[4], v[5]); w.w = cvt_pk_bf16(v[6], v[7]);
            *(u32x4*)(T2 + ((size_t)g * 256 + row) * 384 + kg * 8) = w; }
        for (int it = tid; it < 128 * 32; it += NTHR) { const int q = it >> 5, kg = it & 31, j = kg >> 1, c0 = (kg & 1) * 8, p = q & 63; float v[8];
            const float ar = apr[(15 - j) * 64 + p], ai = api[(15 - j) * 64 + p];
#pragma unroll
            for (int i = 0; i < 8; ++i) { const float br = Br[p * 16 + c0 + i], bi = Bi[p * 16 + c0 + i]; v[i] = (q < 64) ? (ar * br - ai * bi) : (ar * bi + ai * br); }
            u32x4 w; w.x = cvt_pk_bf16(v[0], v[1]); w.y = cvt_pk_bf16(v[2], v[3]); w.z = cvt_pk_bf16(v[4], v[5]); w.w = cvt_pk_bf16(v[6], v[7]);
            *(u32x4*)(T1 + ((size_t)g * 128 + q) * 256 + kg * 8) = w; }
    }
}

__device__ __forceinline__ void modulate_phase(KP& P) { const int tidl_ = ltid();
    const int wid = tidl_ >> 6, lane = tidl_ & 63; const float* mods = (const float*)(P.ws + WS_MODS); bf16_t* hA = (bf16_t*)(P.ws + WS_H);
    const int G_ = gridDim.x, nw = G_ * 8, per = nw >> 3;
    if ((G_ & 7) == 0) {
        const int vb = ((int)blockIdx.x % 8) * (G_ / 8) + (int)blockIdx.x / 8, w = vb * 8 + wid, bseq = w / per, r0 = w - bseq * per;
        const float* sh = mods + (size_t)bseq * NMOD; const float* sc = sh + 1024;
#pragma unroll 2
        for (int l = r0; l < SEQ; l += per) { const size_t row = (size_t)bseq * SEQ + l;
#pragma unroll
            for (int i = 0; i < 4; ++i) { const int c = i * 256 + lane * 4; const f32x4 x = *(const f32x4*)(P.x_p + row * 1024 + c), a = *(const f32x4*)(sc + c), b = *(const f32x4*)(sh + c);
                u32x2 wv; wv.x = cvt_pk_bf16(x[0] * (1.f + a[0]) + b[0], x[1] * (1.f + a[1]) + b[1]); wv.y = cvt_pk_bf16(x[2] * (1.f + a[2]) + b[2], x[3] * (1.f + a[3]) + b[3]);
                *(u32x2*)(hA + row * 1024 + c) = wv; } }
    }
    for (int row = ((G_ & 7) == 0 ? MP : 0) + blockIdx.x * 8 + wid; row < MT; row += G_ * 8) {
        const int ns = row < MP ? (row >> 11) : 8 + (row - MP); const float* xr = row < MP ? P.x_p + (size_t)row * 1024 : P.x_s + (size_t)(row - MP) * 1024;
        const float* sh = mods + (size_t)ns * NMOD; const float* sc = sh + 1024;
#pragma unroll
        for (int i = 0; i < 4; ++i) { const int c = i * 256 + lane * 4; const f32x4 x = *(const f32x4*)(xr + c), a = *(const f32x4*)(sc + c), b = *(const f32x4*)(sh + c);
            u32x2 w; w.x = cvt_pk_bf16(x[0] * (1.f + a[0]) + b[0], x[1] * (1.f + a[1]) + b[1]); w.y = cvt_pk_bf16(x[2] * (1.f + a[2]) + b[2], x[3] * (1.f + a[3]) + b[3]);
            *(u32x2*)(hA + (size_t)row * 1024 + c) = w; }
    }
}
__device__ __forceinline__ void ln_finish(int row, f32x4 (&v)[4], int lane, const f32x4 (&gg)[4], const f32x4 (&bb)[4], const f32x4 (&sh)[4], const f32x4 (&sc)[4], float* xout, bool has_next, bf16_t* hA, float* stats) {
    float s = 0.f;
#pragma unroll
    for (int i = 0; i < 4; ++i) s += (v[i][0] + v[i][1]) + (v[i][2] + v[i][3]);
    const float mean = wave_sum(s) * (1.0f / 1024.0f); float q = 0.f;
#pragma unroll
    for (int i = 0; i < 4; ++i) { const f32x4 d = v[i] - mean; q += (d[0] * d[0] + d[1] * d[1]) + (d[2] * d[2] + d[3] * d[3]); }
    const float rstd = 1.0f / sqrtf(wave_sum(q) * (1.0f / 1024.0f) + LN_EPS);
    if (stats && lane == 0) { stats[(size_t)row * 2] = mean; stats[(size_t)row * 2 + 1] = rstd; }
#pragma unroll
    for (int i = 0; i < 4; ++i) { const int c = i * 256 + lane * 4;
        const f32x4 xn = (v[i] - mean) * rstd * gg[i] + bb[i];
        if (!stats) *(f32x4*)(xout + (size_t)row * 1024 + c) = xn;
        if (has_next) { u32x2 w; w.x = cvt_pk_bf16(xn[0] * (1.f + sc[i][0]) + sh[i][0], xn[1] * (1.f + sc[i][1]) + sh[i][1]); w.y = cvt_pk_bf16(xn[2] * (1.f + sc[i][2]) + sh[i][2], xn[3] * (1.f + sc[i][3]) + sh[i][3]);
            *(u32x2*)(hA + (size_t)row * 1024 + c) = w; } }
}
__device__ __forceinline__ void ln_phase(KP& P, int li, int lj, int smode, int KS, const float* xres_s, int next_off  , bool do_prompt) { const int tidl_ = ltid();
    const int wid = tidl_ >> 6, lane = tidl_ & 63; const float* mods = (const float*)(P.ws + WS_MODS); bf16_t* hA = (bf16_t*)(P.ws + WS_H);
    const bf16_t* T = (const bf16_t*)(P.ws + WS_T); const float* raw = (const float*)(P.ws + WS_RAW);
    const float* lg = P.ln_g + (li * 2 + lj) * 1024; const float* lb = P.ln_b + (li * 2 + lj) * 1024; const int gate_off = ((li * 2 + lj) * 3 + 2) * 1024;
    const int stride = gridDim.x * 8; const bool has_next = next_off >= 0;
    f32x4 gg[4], bb[4], sh[4], sc[4];
#pragma unroll
    for (int i = 0; i < 4; ++i) { const int c = i * 256 + lane * 4; gg[i] = *(const f32x4*)(lg + c); bb[i] = *(const f32x4*)(lb + c); sh[i] = (f32x4){0.f, 0.f, 0.f, 0.f}; sc[i] = sh[i]; }
    if (do_prompt) {
        const int G_ = gridDim.x, vb = (G_ % 8 == 0) ? ((int)blockIdx.x % 8) * (G_ / 8) + (int)blockIdx.x / 8 : (int)blockIdx.x;
        const int nw = stride, w = vb * 8 + wid, per = nw >> 3;
        if ((nw & 7) == 0 && per > 0) {
            const int bseq = w / per, r0 = w - bseq * per;
            if (has_next) {
#pragma unroll
                for (int i = 0; i < 4; ++i) { const int c = i * 256 + lane * 4; sh[i] = *(const f32x4*)(mods + (size_t)bseq * NMOD + next_off + c); sc[i] = *(const f32x4*)(mods + (size_t)bseq * NMOD + next_off + 1024 + c); }
            }
            int l = r0; f32x4 v[4], nx[4];
            if (l < SEQ) {
#pragma unroll
                for (int i = 0; i < 4; ++i) { const u32x2 w = *(const u32x2*)(T + (size_t)(bseq * SEQ + l) * 1024 + i * 256 + lane * 4); v[i] = (f32x4){bflo(w.x), bfhi(w.x), bflo(w.y), bfhi(w.y)}; }
            }
            for (; l < SEQ; l += per) { const int nl = l + per;
                if (nl < SEQ) {
#pragma unroll
                    for (int i = 0; i < 4; ++i) { const u32x2 w = *(const u32x2*)(T + (size_t)(bseq * SEQ + nl) * 1024 + i * 256 + lane * 4); nx[i] = (f32x4){bflo(w.x), bfhi(w.x), bflo(w.y), bfhi(w.y)}; }
                }
                ln_finish(bseq * SEQ + l, v, lane, gg, bb, sh, sc, P.out + O_Y, has_next, hA, (float*)(P.ws + WS_STATS));
#pragma unroll
                for (int i = 0; i < 4; ++i) v[i] = nx[i];
            }
        }
    }
    for (int n = (gridDim.x - 1 - blockIdx.x) * 8 + wid; n < NS; n += stride) {
        const int row = MP + n, ns = 8 + n; f32x4 v[4];
#pragma unroll
        for (int i = 0; i < 4; ++i) { const int c = i * 256 + lane * 4; f32x4 o;
            if (smode == 0) { const f32x4 a = rawsum4(raw, (size_t)n * 2048 + pcol(c), KS, (size_t)128 * 2048), gt = rawsum4(raw, (size_t)n * 2048 + pcol(c) + 128, KS, (size_t)128 * 2048);
#pragma unroll
                for (int j = 0; j < 4; ++j) o[j] = a[j] * sigmoidf_(gt[j]);
            } else o = rawsum4(raw, (size_t)n * 1024 + c, KS, (size_t)128 * 1024);
            const f32x4 xr = *(const f32x4*)(xres_s + (size_t)n * 1024 + c), gm = *(const f32x4*)(mods + (size_t)ns * NMOD + gate_off + c);
            v[i] = ALPHA * xr + gm * o;
            if (has_next) { sh[i] = *(const f32x4*)(mods + (size_t)ns * NMOD + next_off + c); sc[i] = *(const f32x4*)(mods + (size_t)ns * NMOD + next_off + 1024 + c); } }
        ln_finish(row, v, lane, gg, bb, sh, sc, P.out + O_Y, has_next, hA, nullptr);
    }
}

__device__ __forceinline__ void s5_prompt(KP& P, LAS unsigned char* lds) {
    bf16_t* A2 = (bf16_t*)(P.ws + WS_T); bf16_t* hA = (bf16_t*)(P.ws + WS_H);
    for (int idx = blockIdx.x; idx < 256; idx += gridDim.x) {
        const int g = idx >> 2, pm = idx & 3;
        bf16_t* A2g = A2 + (size_t)g * 1024 * 384;
        float* Slg = (float*)(P.ws + WS_BIG + BIG_SLOC) + (size_t)g * 1024 * 128;
        { Gemm gm{A2g, (const bf16_t*)(P.ws + WS_BIG + BIG_TAB1) + (size_t)g * 128 * 256, 384, 256, 256}; OneUnit S{{pm, 0}}; EpiS1 E{Slg}; gemm_phase(lds, gm, S, E); }
        asm volatile("s_waitcnt vmcnt(0)" ::: "memory"); __syncthreads();
        {
            const int tid = ltid();
            const int nl = tid >> 8, seg = (tid >> 6) & 3, p = tid & 63; const int rowbase = pm * 256 + nl * 128 + seg * 32;
            const float* sl = Slg + (size_t)rowbase * 128; float lre[32], lim[32];
#pragma unroll
            for (int k = 0; k < 32; ++k) { lre[k] = sl[k * 128 + p]; lim[k] = sl[k * 128 + 64 + p]; }
            const float* sc = (const float*)(P.ws + WS_S5C) + (size_t)(g * 64 + p) * 8;
            const float a16r = sc[2], a16i = sc[3], a512r = sc[4], a512i = sc[5];
            float sr = 0.f, si = 0.f;
#pragma unroll
            for (int k = 0; k < 32; ++k) { const float nr = a16r * sr - a16i * si + lre[k], ni = a16r * si + a16i * sr + lim[k]; sr = nr; si = ni; lre[k] = sr; lim[k] = si; }
            LAS float* Eb = (LAS float*)lds;
            Eb[((nl * 4 + seg) * 64 + p) * 2] = sr; Eb[((nl * 4 + seg) * 64 + p) * 2 + 1] = si;
            __syncthreads();
            float cr = 0.f, ci = 0.f;
            for (int s2 = 0; s2 < seg; ++s2) { const float er = Eb[((nl * 4 + s2) * 64 + p) * 2], ei = Eb[((nl * 4 + s2) * 64 + p) * 2 + 1];
                const float nr = a512r * cr - a512i * ci + er, ni = a512r * ci + a512i * cr + ei; cr = nr; ci = ni; }
            float pwr = 1.f, pwi = 0.f; bf16_t* dst = A2g + (size_t)rowbase * 384 + 256 + p;
#pragma unroll
            for (int k = 0; k < 32; ++k) { float vr, vi;
                if (k == 0) { vr = cr; vi = ci; } else { vr = lre[k - 1] + (pwr * cr - pwi * ci); vi = lim[k - 1] + (pwr * ci + pwi * cr); }
                const unsigned w = cvt_pk_bf16(vr, vi); dst[(size_t)k * 384] = (bf16_t)(w & 0xffffu); dst[(size_t)k * 384 + 64] = (bf16_t)(w >> 16);
                const float nr = pwr * a16r - pwi * a16i, ni = pwr * a16i + pwi * a16r; pwr = nr; pwi = ni; }
            if (seg == 3) { const int n = pm * 2 + nl;
                P.out[O_S5RE_P + (size_t)(n * 64 + g) * 64 + p] = lre[31] + (pwr * cr - pwi * ci);
                P.out[O_S5IM_P + (size_t)(n * 64 + g) * 64 + p] = lim[31] + (pwr * ci + pwi * cr); }
        }
        asm volatile("s_waitcnt vmcnt(0)" ::: "memory"); __syncthreads();
        { Gemm gm{A2g, (const bf16_t*)(P.ws + WS_BIG + BIG_TAB2) + (size_t)g * 256 * 384, 384, 384, 384}; OneUnit S{{pm, 0}}; EpiS2 E{A2g, P.s5_d, hA, g}; gemm_phase(lds, gm, S, E); }
        __syncthreads();
    }
}
__device__ __forceinline__ void s5_sample(KP& P) { const int tidl_ = ltid();
    const int wid = tidl_ >> 6, lane = tidl_ & 63; const float* raw = (const float*)(P.ws + WS_RAW); bf16_t* hA = (bf16_t*)(P.ws + WS_H);
    for (int wi = blockIdx.x * 8 + wid; wi < 2048; wi += gridDim.x * 8) {
        const int g = wi >> 5, n0 = (wi & 31) * 4, p = lane;
        const float* sc = (const float*)(P.ws + WS_S5C) + (size_t)(g * 64 + p) * 8; const float far = sc[0], fai = sc[1];
        const float* bbp = (const float*)(P.ws + WS_BBAR) + (size_t)(g * 64 + p) * 32;
        float Bre[16], Bim[16], Cre[16], Cim[16];
#pragma unroll
        for (int c = 0; c < 16; ++c) { Bre[c] = bbp[c * 2]; Bim[c] = bbp[c * 2 + 1];
            Cre[c] = P.c_re[(g * 16 + c) * 64 + p]; Cim[c] = P.c_im[(g * 16 + c) * 64 + p]; }
        const int cl = ((lane & 1) << 3) | ((lane & 2) << 1) | ((lane & 4) >> 1) | ((lane & 8) >> 3);
        const float dl = P.s5_d[g * 16 + cl];
        for (int nn = 0; nn < 4; ++nn) { const int n = n0 + nn;
            const float h0r = P.s5re[(size_t)(n * 64 + g) * 64 + p], h0i = P.s5im[(size_t)(n * 64 + g) * 64 + p];
            float sr = far * h0r - fai * h0i, si = far * h0i + fai * h0r;
#pragma unroll
            for (int c = 0; c < 16; ++c) { const float uc = raw[(size_t)n * 1024 + g * 16 + c]; sr += Bre[c] * uc; si += Bim[c] * uc; }
            P.out[O_S5RE_S + (size_t)(n * 64 + g) * 64 + p] = sr; P.out[O_S5IM_S + (size_t)(n * 64 + g) * 64 + p] = si;
            float v16[16];
#pragma unroll
            for (int c = 0; c < 16; ++c) v16[c] = Cre[c] * sr - Cim[c] * si;
            const bool b0 = lane & 1, b1 = lane & 2, b2 = lane & 4, b3 = lane & 8;
            float r8[8], s4[4], t2[2];
#pragma unroll
            for (int j = 0; j < 8; ++j) { const float mine = b0 ? v16[j + 8] : v16[j], send = b0 ? v16[j] : v16[j + 8]; r8[j] = mine + dppx<0xB1>(send); }
#pragma unroll
            for (int j = 0; j < 4; ++j) { const float mine = b1 ? r8[j + 4] : r8[j], send = b1 ? r8[j] : r8[j + 4]; s4[j] = mine + dppx<0x4E>(send); }
#pragma unroll
            for (int j = 0; j < 2; ++j) { const float mine = b2 ? s4[j + 2] : s4[j], send = b2 ? s4[j] : s4[j + 2]; t2[j] = mine + __shfl_xor(send, 4); }
            float ysel; { const float mine = b3 ? t2[1] : t2[0], send = b3 ? t2[0] : t2[1]; ysel = mine + dppx<0x128>(send); }
            ysel += __shfl_xor(ysel, 16); ysel += __shfl_xor(ysel, 32);
            if (lane < 16) { const float ul = raw[(size_t)n * 1024 + g * 16 + cl]; const float y = gelu_tanh(ysel + dl * ul);
                hA[(size_t)(MP + n) * 1024 + g * 16 + cl] = (bf16_t)(cvt_pk_bf16(y, 0.f) & 0xffffu); }
        }
    }
}

__device__ __forceinline__ void unpack8(const u32x4 w, float (&f)[8]) { f[0] = bflo(w.x); f[1] = bfhi(w.x); f[2] = bflo(w.y); f[3] = bfhi(w.y); f[4] = bflo(w.z); f[5] = bfhi(w.z); f[6] = bflo(w.w); f[7] = bfhi(w.w); }
__device__ __forceinline__ void ld8(const float* p, float (&f)[8]) { const f32x4 a = *(const f32x4*)p, b = *(const f32x4*)(p + 4); f[0] = a[0]; f[1] = a[1]; f[2] = a[2]; f[3] = a[3]; f[4] = b[0]; f[5] = b[1]; f[6] = b[2]; f[7] = b[3]; }
__device__ __forceinline__ void st8(float* p, const float (&f)[8]) { *(f32x4*)p = (f32x4){f[0], f[1], f[2], f[3]}; *(f32x4*)(p + 4) = (f32x4){f[4], f[5], f[6], f[7]}; }
__device__ __forceinline__ void ffn_fixup_rows(KP& P, int layer, int pm) { const int tidl_ = ltid();
    const bf16_t* halo = (const bf16_t*)(P.ws + WS_BIG + BIG_HALO); bf16_t* act = (bf16_t*)(P.ws + WS_BIG);
    const float* cw = P.ffn_conv_w + (size_t)layer * 3 * DFF2; const float* cb = P.ffn_conv_b + (size_t)layer * DFF2;
    constexpr int NOCT = DFF / 8;
    for (int id = tidl_; id < 4 * NOCT; id += NTHR) {
        float x0[2][8], x1[2][8], x2[2][8], w0[2][8], w1[2][8], w2[2][8], bb[2][8];
        const int loc = id / NOCT, oct = id - loc * NOCT, c0 = oct * 8;
        const int blk = pm * 2 + (loc >> 1), rr = loc & 1; const bool hp = (blk & 15) != 0; const size_t orow = (size_t)(blk * 128 + rr);
        const bf16_t* h0 = halo + (size_t)(blk * 4 + rr) * DFF2;
        const bf16_t* h1 = rr ? halo + (size_t)(blk * 4) * DFF2 : halo + (size_t)((blk - 1) * 4 + 3) * DFF2; const bool v1 = rr ? true : hp;
        const bf16_t* h2 = rr ? halo + (size_t)((blk - 1) * 4 + 3) * DFF2 : halo + (size_t)((blk - 1) * 4 + 2) * DFF2; const bool v2 = hp;
#pragma unroll
        for (int part = 0; part < 2; ++part) { const int col = part * DFF + c0;
            unpack8(*(const u32x4*)(h0 + col), x0[part]);
            if (v1) unpack8(*(const u32x4*)(h1 + col), x1[part]); else { for (int j = 0; j < 8; ++j) x1[part][j] = 0.f; }
            if (v2) unpack8(*(const u32x4*)(h2 + col), x2[part]); else { for (int j = 0; j < 8; ++j) x2[part][j] = 0.f; }
            ld8(cw + col, w0[part]); ld8(cw + DFF2 + col, w1[part]); ld8(cw + 2 * DFF2 + col, w2[part]); ld8(cb + col, bb[part]); }
        float o[8];
#pragma unroll
        for (int j = 0; j < 8; ++j) { const float cv = w2[0][j] * x0[0][j] + w1[0][j] * x1[0][j] + w0[0][j] * x2[0][j] + bb[0][j], cg_ = w2[1][j] * x0[1][j] + w1[1][j] * x1[1][j] + w0[1][j] * x2[1][j] + bb[1][j];
            o[j] = gelu_tanh(cg_) * cv; }
        u32x4 w; w.x = cvt_pk_bf16(o[0], o[1]); w.y = cvt_pk_bf16(o[2], o[3]); w.z = cvt_pk_bf16(o[4], o[5]); w.w = cvt_pk_bf16(o[6], o[7]);
        *(u32x4*)(act + orow * DFF + c0) = w;
    }
    asm volatile("s_waitcnt vmcnt(0)" ::: "memory"); __syncthreads();
}

__device__ __forceinline__ void shortconv_phase(KP& P) { const int tidl_ = ltid();
    const int G = gridDim.x; const bf16_t* z2 = (const bf16_t*)(P.ws + WS_BIG); bf16_t* hA = (bf16_t*)(P.ws + WS_H); const float* raw = (const float*)(P.ws + WS_RAW);
    const int c0 = (tidl_ & 127) * 8; float w0[8], w1[8], w2[8];
    ld8(P.sc_conv_w + c0, w0); ld8(P.sc_conv_w + 1024 + c0, w1); ld8(P.sc_conv_w + 2048 + c0, w2);
    const int vb_ = (G % 8 == 0) ? ((int)blockIdx.x % 8) * (G / 8) + (int)blockIdx.x / 8 : (int)blockIdx.x;
    const bool al_ = (G == 256); const int nk_ = al_ ? 16 : (MP + G * 4 - 1) / (G * 4);
#pragma unroll 4
    for (int k_ = 0; k_ < nk_; ++k_) { const int r = al_ ? (vb_ >> 5) * SEQ + (vb_ & 31) * 4 + (tidl_ >> 7) + 128 * k_ : (int)blockIdx.x * 4 + (tidl_ >> 7) + k_ * G * 4; if (r >= MP) break;
        const int l = r & 2047; float cur[8], m1[8], m2[8], gb[8], q[8];
        unpack8(*(const u32x4*)(z2 + (size_t)r * 2048 + 1024 + c0), cur); unpack8(*(const u32x4*)(z2 + (size_t)r * 2048 + c0), gb);
        if (l >= 1) unpack8(*(const u32x4*)(z2 + (size_t)(r - 1) * 2048 + 1024 + c0), m1); else { for (int j = 0; j < 8; ++j) m1[j] = 0.f; }
        if (l >= 2) unpack8(*(const u32x4*)(z2 + (size_t)(r - 2) * 2048 + 1024 + c0), m2); else { for (int j = 0; j < 8; ++j) m2[j] = 0.f; }
#pragma unroll
        for (int j = 0; j < 8; ++j) q[j] = gb[j] * (w0[j] * m2[j] + w1[j] * m1[j] + w2[j] * cur[j]);
        u32x4 w; w.x = cvt_pk_bf16(q[0], q[1]); w.y = cvt_pk_bf16(q[2], q[3]); w.z = cvt_pk_bf16(q[4], q[5]); w.w = cvt_pk_bf16(q[6], q[7]);
        *(u32x4*)(hA + (size_t)r * 1024 + c0) = w;
        if (l >= 2046) st8(P.out + O_CONV_P + (size_t)((r >> 11) * 2 + (l - 2046)) * 1024 + c0, cur);
    }
    for (int id = (G - 1 - (int)blockIdx.x) * NTHR + tidl_; id < NS * 128; id += G * NTHR) {
        const int n = id >> 7; float gb[8], gc[8], v[8], b0[8], b1[8], cvs[8], q[8];
        ld8(raw + (size_t)n * 3072 + c0, gb); ld8(raw + (size_t)n * 3072 + 1024 + pcol(c0), gc); ld8(raw + (size_t)n * 3072 + 1024 + pcol(c0) + 128, v);
        ld8(P.st_conv + (size_t)(n * 2) * 1024 + c0, b0); ld8(P.st_conv + (size_t)(n * 2 + 1) * 1024 + c0, b1);
#pragma unroll
        for (int j = 0; j < 8; ++j) { cvs[j] = gc[j] * v[j]; q[j] = gb[j] * (w0[j] * b0[j] + w1[j] * b1[j] + w2[j] * cvs[j]); }
        st8(P.out + O_CONV_S + (size_t)(n * 2) * 1024 + c0, b1); st8(P.out + O_CONV_S + (size_t)(n * 2 + 1) * 1024 + c0, cvs);
        u32x4 w; w.x = cvt_pk_bf16(q[0], q[1]); w.y = cvt_pk_bf16(q[2], q[3]); w.z = cvt_pk_bf16(q[4], q[5]); w.w = cvt_pk_bf16(q[6], q[7]);
        *(u32x4*)(hA + (size_t)(MP + n) * 1024 + c0) = w;
    }
}

#define XB_TMO      128
#define XB_XCNT(j)  (256  + 64 * (j))
#define XB_XSUB(j)  (1280 + 64 * (j))
#define XB_XGEN(j)  (2304 + 64 * (j))
#define XB_TOP      3328
#define XB_TOPGEN   3392
#define XCD_BAR_WORDS 3456
#define XB_SPIN_CAP (1u << 20)
__device__ __forceinline__ unsigned xb_ld(unsigned* p)              { return __hip_atomic_load(p, __ATOMIC_RELAXED, __HIP_MEMORY_SCOPE_AGENT); }
__device__ __forceinline__ unsigned xb_add(unsigned* p, unsigned v) { return __hip_atomic_fetch_add(p, v, __ATOMIC_RELAXED, __HIP_MEMORY_SCOPE_AGENT); }
__device__ __forceinline__ unsigned xb_xcc_id() { return (unsigned)__builtin_amdgcn_s_getreg((3 << 11) | 20) & 0xFu; }
#define XB_SPIN(cond, bar) do { unsigned _sp = 0; while (cond) { __builtin_amdgcn_s_sleep(1); \
    if ((++_sp & 255u) == 0u) { if (xb_ld(&(bar)[XB_TMO])) break; if (_sp > XB_SPIN_CAP) { atomicAdd(&(bar)[XB_TMO], 1u); break; } } } } while (0)
__device__ __forceinline__ void xcd_barrier_complete(unsigned* bar, unsigned x, unsigned& nloc, unsigned& nx) {
    const unsigned G = gridDim.x; unsigned sum, cnt, mine, sp = 0u;
    for (;;) {
        sum = 0u; cnt = 0u; mine = 0u;
#pragma unroll
        for (unsigned j = 0; j < 16; ++j) { const unsigned c = xb_ld(&bar[XB_XCNT(j)]); sum += c; cnt += (c > 0u) ? 1u : 0u; mine = (j == x) ? c : mine; }
        if (sum == G) break;
        __builtin_amdgcn_s_sleep(1);
        if ((++sp & 255u) == 0u) { if (xb_ld(&bar[XB_TMO])) break; if (sp > XB_SPIN_CAP) { atomicAdd(&bar[XB_TMO], 1u); break; } }
    }
    nloc = mine > 0u ? mine : 1u; nx = cnt > 0u ? cnt : 1u;
}
__device__ __forceinline__ void grid_bar(unsigned* bar, volatile LAS unsigned* st) {
    asm volatile("s_waitcnt vmcnt(0)" ::: "memory");
    __syncthreads();
    if (ltid() == 0) {
        const unsigned x = xb_xcc_id();
        __builtin_amdgcn_s_waitcnt(0);
        unsigned nloc = st[0], nx = st[1];
        if (nloc == 0u) { xcd_barrier_complete(bar, x, nloc, nx); st[0] = nloc; st[1] = nx; }
        const unsigned old = xb_add(&bar[XB_XSUB(x)], 1u);
        const unsigned gen = old / nloc;
        if (old + 1u == (gen + 1u) * nloc) {
            __builtin_amdgcn_fence(__ATOMIC_RELEASE, "agent");
            asm volatile("s_waitcnt vmcnt(0)" ::: "memory");
            const unsigned og = xb_add(&bar[XB_TOP], 1u);
            const unsigned tg = og / nx;
            if (og + 1u == (tg + 1u) * nx) xb_add(&bar[XB_TOPGEN], 1u);
            else XB_SPIN(xb_ld(&bar[XB_TOPGEN]) == tg, bar);
            __builtin_amdgcn_fence(__ATOMIC_ACQUIRE, "agent");
            xb_add(&bar[XB_XGEN(x)], 1u);
            asm volatile("s_waitcnt vmcnt(0)" ::: "memory");
        } else {
            XB_SPIN(xb_ld(&bar[XB_XGEN(x)]) == gen, bar);
            __builtin_amdgcn_fence(__ATOMIC_ACQUIRE, "agent");
            asm volatile("s_waitcnt vmcnt(0)" ::: "memory");
        }
    }
    __syncthreads();
}

__device__ __forceinline__ void sample_gate(KP& P, int slot) {
    const int r = (int)gridDim.x - 1 - (int)blockIdx.x; unsigned* c = (unsigned*)(P.ws + WS_CNT) + 3072 + 96 + slot * 16;
    asm volatile("s_waitcnt vmcnt(0)" ::: "memory"); __syncthreads();
    if (ltid() == 0) {
        if (r < 64) { __builtin_amdgcn_fence(__ATOMIC_RELEASE, "agent"); asm volatile("s_waitcnt vmcnt(0)" ::: "memory"); __hip_atomic_fetch_add(c, 1u, __ATOMIC_RELAXED, __HIP_MEMORY_SCOPE_AGENT); }
        if (r < 16) { unsigned spins = 0; while (__hip_atomic_load(c, __ATOMIC_RELAXED, __HIP_MEMORY_SCOPE_AGENT) < 64u) { __builtin_amdgcn_s_sleep(2); if (++spins > (1u << 22)) break; }
            __builtin_amdgcn_fence(__ATOMIC_ACQUIRE, "agent"); asm volatile("s_waitcnt vmcnt(0)" ::: "memory"); }
    }
    __syncthreads();
}

__global__ void __launch_bounds__(NTHR) fwd_kernel(Params P_unused) {
    LAS unsigned char* lds = (LAS unsigned char*)lds_raw;
    { const unsigned slot = (unsigned)__builtin_amdgcn_s_getreg((5 << 11) | 4) & 63u; if ((threadIdx.x & 63) == 0) ((volatile LAS int*)(lds + LDS_WTAB))[slot] = (int)(threadIdx.x >> 6); __syncthreads(); }
    const int G = gridDim.x, bx = blockIdx.x;
    const int lo = getP().ph_lo, hi = getP().ph_hi;
    if (lo < 0) cg::this_grid().sync();
#define BST ((volatile LAS unsigned*)((LAS unsigned char*)lds_raw + 131072 + 64))
    if (ltid() == 0) { BST[0] = 0u; BST[1] = 0u; if (hi - lo > 1) (void)xb_add(&((unsigned*)(getP().ws + WS_BAR))[XB_XCNT(xb_xcc_id())], 1u); }
    __syncthreads();
#define GBAR() do { grid_bar((unsigned*)(getP().ws + WS_BAR), BST); } while (0)
#define PHASE_VARS KP& P = getP(); unsigned char* ws = P.ws; const float* mods = (const float*)(ws + WS_MODS); bf16_t* hA = (bf16_t*)(ws + WS_H); float* T = (float*)(ws + WS_T); float* raw = (float*)(ws + WS_RAW); bf16_t* act = (bf16_t*)(ws + WS_BIG); \
    (void)mods; (void)hA; (void)T; (void)raw; (void)act;
#ifndef ONLYP
#define ONLYP (-1)
#endif
#define IN(k) ((ONLYP < 0 || (k) == ONLYP) && lo <= (k) && (k) < hi)
#define SEAM(k) do { if (IN(k) && IN((k) + 1)) { GBAR(); for (int xs_ = 0; xs_ < XSYNC; ++xs_) GBAR(); } } while (0)
#define MOD_OFF(i, j, k) ((((i) * 2 + (j)) * 3 + (k)) * 1024)

    if (IN(0)) for (int rep_ = 0; rep_ < 1 + (int)((REPMASK >> (0)) & 1u); ++rep_) { if (rep_) GBAR(); PHASE_VARS
        p0_s5_tables(P, (LAS float*)lds); __syncthreads();
        mods_phase(P, (LAS float*)lds, (G == 256) ? (bx >= 64 ? bx - 64 : (1 << 30)) : bx, (G == 256) ? 192 : G);
        p0_convert(P, (LAS float*)lds); } SEAM(0);
    if (IN(2)) for (int rep_ = 0; rep_ < 1 + (int)((REPMASK >> (2)) & 1u); ++rep_) { if (rep_) GBAR(); PHASE_VARS modulate_phase(P); } SEAM(2);
    if (IN(3)) for (int rep_ = 0; rep_ < 1 + (int)((REPMASK >> (3)) & 1u); ++rep_) { if (rep_) GBAR(); PHASE_VARS
        { Gemm g{hA, (const bf16_t*)(ws + WS_WIN), 1024, 1024, 1024}; StaticOrder S; S.init(MP, 1024, G, bx); EpiWin E{(bf16_t*)(ws + WS_T)}; gemm_phase(lds, g, S, E); }
        skinny3((LAS float*)lds, hA + (size_t)MP * 1024, 1024, (const bf16_t*)(ws + WS_WIN), 1024, raw, G - 1 - bx, G);
    } SEAM(3);
    if (IN(4)) for (int rep_ = 0; rep_ < 1 + (int)((REPMASK >> (4)) & 1u); ++rep_) { if (rep_) GBAR(); PHASE_VARS for (int q_ = 0; q_ < S5P_REP; ++q_) s5_prompt(P, lds); for (int q_ = 0; q_ < S5S_REP; ++q_) s5_sample(P); } SEAM(4);
    if (IN(5)) for (int rep_ = 0; rep_ < 1 + (int)((REPMASK >> (5)) & 1u); ++rep_) { if (rep_) GBAR(); PHASE_VARS
        { Gemm g{hA, (const bf16_t*)(ws + WS_WGLU), 1024, 1024, 1024}; StaticOrder S; S.init(MP, 2048, G, bx); EpiGlu E{P.x_p, mods + MOD_OFF(0, 0, 2), (bf16_t*)T}; gemm_phase(lds, g, S, E); }
        skinny3((LAS float*)lds, hA + (size_t)MP * 1024, 1024, (const bf16_t*)(ws + WS_WGLU), 2048, raw, G - 1 - bx, G);
    } SEAM(5);
    if (IN(6)) for (int rep_ = 0; rep_ < 1 + (int)((REPMASK >> (6)) & 1u); ++rep_) { if (rep_) GBAR(); PHASE_VARS ln_phase(P, 0, 0, 0, 1, P.x_s, MOD_OFF(0, 1, 0), true); } SEAM(6);
#pragma unroll 1
    for (int layer = 0; layer < 2; ++layer) {
        const int pb = layer ? 15 : 7;
        if (IN(pb)) for (int rep_ = 0; rep_ < 1 + (int)((REPMASK >> (pb)) & 1u); ++rep_) { if (rep_) GBAR(); PHASE_VARS
            { Gemm g{hA, (const bf16_t*)(ws + WS_UP) + (size_t)layer * DFF2 * 1024, 1024, 1024, 1024}; StaticOrder S; S.init(MP, DFF2, G, bx);
              EpiUp E{act, (bf16_t*)(ws + WS_BIG + BIG_HALO), P.out + O_FFN_P + (size_t)layer * NB * 2 * DFF2, P.ffn_conv_w + (size_t)layer * 3 * DFF2, P.ffn_conv_b + (size_t)layer * DFF2};
              gemm_phase(lds, g, S, E); }
            skinny_up(P, layer, (LAS float*)lds, hA + (size_t)MP * 1024, (const bf16_t*)(ws + WS_UP) + (size_t)layer * DFF2 * 1024, (G == 256) ? (bx >= 128 ? bx - 128 : (1 << 30)) : G - 1 - bx, (G == 256) ? 128 : G);
        } SEAM(pb);
        if (IN(pb + 2)) for (int rep_ = 0; rep_ < 1 + (int)((REPMASK >> (pb + 2)) & 1u); ++rep_) { if (rep_) GBAR(); PHASE_VARS
            { Gemm g{act, (const bf16_t*)(ws + WS_DOWN) + (size_t)layer * 1024 * DFF, DFF, DFF, DFF}; StaticOrder S; S.init(MP, 1024, G, bx);
              { Unit u0; if (S.next(0, u0)) ffn_fixup_rows(P, layer, u0.pm); }
              if (layer == 0) { EpiLnT<1, false> E{nullptr, (bf16_t*)(ws + WS_T + (size_t)32 * 1024 * 1024), (const bf16_t*)T, (const float*)(ws + WS_STATS), P.ln_g, P.ln_b, nullptr, mods, MOD_OFF(0, 1, 2), MOD_OFF(1, 0, 0), P.ln_g + 1024, P.ln_b + 1024, P.out + O_Y, hA, (unsigned long long*)(ws + WS_XBUF), (unsigned*)(ws + WS_CNT)};
                  gemm_phase(lds, g, S, E); }
              else { EpiLnT<2, true> E{(bf16_t*)(ws + WS_T + (size_t)32 * 1024 * 1024), nullptr, nullptr, nullptr, nullptr, nullptr, nullptr, mods, MOD_OFF(1, 1, 2), -1, P.ln_g + 3 * 1024, P.ln_b + 3 * 1024, P.out + O_Y, hA, (unsigned long long*)(ws + WS_XBUF), (unsigned*)(ws + WS_CNT) + 2048};
                  gemm_phase(lds, g, S, E); } }
            skinny3((LAS float*)lds, act + (size_t)MP * DFF, DFF, (const bf16_t*)(ws + WS_DOWN) + (size_t)layer * 1024 * DFF, 1024, raw, G - 1 - bx, G);
            if (G == 256) { sample_gate(P, layer ? 2 : 0); ln_phase(P, layer, 1, 1, 1, P.out + O_Y + (size_t)MP * 1024, layer ? -1 : MOD_OFF(1, 0, 0), false); }
        } if (layer == 0 || G != 256) SEAM(pb + 2);
        if (G != 256 && IN(pb + 3)) for (int rep_ = 0; rep_ < 1 + (int)((REPMASK >> (pb + 3)) & 1u); ++rep_) { if (rep_) GBAR(); PHASE_VARS ln_phase(P, layer, 1, 1, 1, P.out + O_Y + (size_t)MP * 1024, layer ? -1 : MOD_OFF(1, 0, 0), false); }
        if (layer == 0 && G != 256) SEAM(pb + 3);
        if (layer == 0) {
            if (IN(11)) for (int rep_ = 0; rep_ < 1 + (int)((REPMASK >> (11)) & 1u); ++rep_) { if (rep_) GBAR(); PHASE_VARS
                { Gemm g{hA, (const bf16_t*)(ws + WS_SCIN) + (size_t)1024 * 1024, 1024, 1024, 1024}; StaticOrder S; S.init(MP, 2048, G, bx); EpiCv E{(bf16_t*)(ws + WS_BIG)}; gemm_phase(lds, g, S, E); }
                { Gemm g{hA, (const bf16_t*)(ws + WS_SCIN), 1024, 1024, 1024}; StaticOrder S; S.init(MP, 1024, G, bx); EpiGateB E{(bf16_t*)(ws + WS_BIG)}; gemm_phase(lds, g, S, E); }
                skinny3((LAS float*)lds, hA + (size_t)MP * 1024, 1024, (const bf16_t*)(ws + WS_SCIN), 3072, raw, G - 1 - bx, G);
            } SEAM(11);
            if (IN(12)) for (int rep_ = 0; rep_ < 1 + (int)((REPMASK >> (12)) & 1u); ++rep_) { if (rep_) GBAR(); PHASE_VARS shortconv_phase(P); } SEAM(12);
            if (IN(13)) for (int rep_ = 0; rep_ < 1 + (int)((REPMASK >> (13)) & 1u); ++rep_) { if (rep_) GBAR(); PHASE_VARS
                { Gemm g{hA, (const bf16_t*)(ws + WS_SCOUT), 1024, 1024, 1024}; StaticOrder S; S.init(MP, 1024, G, bx);
                  EpiLnT<2, false> E{(bf16_t*)(ws + WS_T + (size_t)32 * 1024 * 1024), (bf16_t*)(ws + WS_T + (size_t)32 * 1024 * 1024), nullptr, nullptr, nullptr, nullptr, nullptr, mods, MOD_OFF(1, 0, 2), MOD_OFF(1, 1, 0), P.ln_g + 2 * 1024, P.ln_b + 2 * 1024, P.out + O_Y, hA, (unsigned long long*)(ws + WS_XBUF), (unsigned*)(ws + WS_CNT) + 1024};
                  gemm_phase(lds, g, S, E); }
                skinny3((LAS float*)lds, hA + (size_t)MP * 1024, 1024, (const bf16_t*)(ws + WS_SCOUT), 1024, raw, G - 1 - bx, G);
                if (G == 256) { sample_gate(P, 1); ln_phase(P, 1, 0, 1, 1, P.out + O_Y + (size_t)MP * 1024, MOD_OFF(1, 1, 0), false); }
            } SEAM(13);
            if (G != 256 && IN(14)) for (int rep_ = 0; rep_ < 1 + (int)((REPMASK >> (14)) & 1u); ++rep_) { if (rep_) GBAR(); PHASE_VARS ln_phase(P, 1, 0, 1, 1, P.out + O_Y + (size_t)MP * 1024, MOD_OFF(1, 1, 0), false); } if (G != 256) SEAM(14);
        }
    }
}

extern "C" void kernel_launch(void* const* d_in, const int* in_sizes, int n_in, void* d_out, int out_size, void* d_ws, size_t ws_size, hipStream_t stream) {
    static int grid = 0;
    if (grid == 0) {
        if (n_in != 29 || (size_t)out_size != O_END || ws_size < WS_END) { fprintf(stderr, "kernel_launch: unexpected shapes: n_in %d out %d ws %zu (need %zu)\n", n_in, out_size, ws_size, (size_t)WS_END); grid = -1; return; }
        int dev = 0, cus = 0, per_cu = 0;
        hipGetDevice(&dev); hipDeviceGetAttribute(&cus, hipDeviceAttributeMultiprocessorCount, dev);
        if (hipFuncSetAttribute((const void*)fwd_kernel, hipFuncAttributeMaxDynamicSharedMemorySize, LDS_BYTES) != hipSuccess) { fprintf(stderr, "kernel_launch: hipFuncSetAttribute failed\n"); grid = -1; return; }
        if (hipOccupancyMaxActiveBlocksPerMultiprocessor(&per_cu, (const void*)fwd_kernel, NTHR, LDS_BYTES) != hipSuccess || per_cu < 1) { fprintf(stderr, "kernel_launch: occupancy query gives %d\n", per_cu); per_cu = 1; }
        (void)hipGetLastError();
        grid = cus;
    }
    if (grid < 0) return;
    Params p{};
    const float** pp = (const float**)&p;
    for (int i = 0; i < 29; ++i) pp[i] = (const float*)d_in[i];
    p.out = (float*)d_out; p.ws = (unsigned char*)d_ws;
#if ONE_LAUNCH
    p.ph_lo = 0; p.ph_hi = NPHASE;
    if (hipMemsetAsync((char*)d_ws + WS_BAR, 0, 32768, stream) != hipSuccess) { fprintf(stderr, "kernel_launch: memset of the barrier word failed\n"); return; }
    void* args[] = {&p};
    hipError_t e = hipLaunchCooperativeKernel((const void*)fwd_kernel, dim3(grid), dim3(NTHR), args, LDS_BYTES, stream);
    if (e != hipSuccess) fprintf(stderr, "cooperative launch failed: %s (grid %d)\n", hipGetErrorString(e), grid);
#else
    for (int ph = 0; ph < NPHASE; ++ph) { p.ph_lo = ph; p.ph_hi = ph + 1; hipLaunchKernelGGL(fwd_kernel, dim3(grid), dim3(NTHR), LDS_BYTES, stream, p); }
#endif
}
```

```cpp
#include <hip/hip_runtime.h>
#include <hip/hip_cooperative_groups.h>
#include <cstdio>
namespace cg = cooperative_groups;

#ifndef ONE_LAUNCH
#define ONE_LAUNCH 1
#endif

#ifndef REPMASK
#define REPMASK 0u
#endif
#ifndef SKREP
#define SKREP 1
#endif
#ifndef S5P_REP
#define S5P_REP 1
#endif
#ifndef S5S_REP
#define S5S_REP 1
#endif
#ifndef XSYNC
#define XSYNC 0
#endif
#define LAS __attribute__((address_space(3)))
typedef unsigned short bf16_t;
typedef short bf16x8 __attribute__((ext_vector_type(8)));
typedef float f32x4 __attribute__((ext_vector_type(4)));
typedef unsigned u32x4 __attribute__((ext_vector_type(4)));
typedef unsigned u32x2 __attribute__((ext_vector_type(2)));

constexpr int D = 1024, SEQ = 2048, NB = 8, MP = NB * SEQ, NS = 128, MT = MP + NS;
constexpr int DFF = 2816, DFF2 = 5632, NMOD = 12288;
constexpr float ALPHA = 1.41421356237309515f;
constexpr float LN_EPS = 1e-5f;
constexpr int NTHR = 512;
constexpr int LDS_BYTES = 131072 + 2048;
constexpr int NPHASE = 19;

constexpr size_t WS_WIN = 0;
constexpr size_t WS_WGLU = WS_WIN + (size_t)1024 * 1024 * 2;
constexpr size_t WS_SCIN = WS_WGLU + (size_t)2048 * 1024 * 2;
constexpr size_t WS_SCOUT = WS_SCIN + (size_t)3072 * 1024 * 2;
constexpr size_t WS_UP = WS_SCOUT + (size_t)1024 * 1024 * 2;
constexpr size_t WS_DOWN = WS_UP + (size_t)2 * 5632 * 1024 * 2;
constexpr size_t WS_H = WS_DOWN + (size_t)2 * 1024 * 2816 * 2;
constexpr size_t WS_T = WS_H + (size_t)MT * 1024 * 2;
constexpr size_t WS_BIG = WS_T + (size_t)MT * 1024 * 4;
constexpr size_t BIG_TAB1 = 0;
constexpr size_t BIG_TAB2 = BIG_TAB1 + (size_t)64 * 128 * 256 * 2;
constexpr size_t BIG_SLOC = BIG_TAB2 + (size_t)64 * 256 * 384 * 2;
constexpr size_t BIG_HALO = (size_t)MT * 2816 * 2;
constexpr size_t WS_MODS = WS_BIG + BIG_HALO + (size_t)128 * 4 * 5632 * 2;
constexpr size_t WS_RAW = WS_MODS + (size_t)136 * NMOD * 4;
constexpr size_t WS_AC = WS_RAW + (size_t)4 * 128 * 3072 * 4;
constexpr size_t WS_S5C = WS_AC + (size_t)144 * 1024 * 2;
constexpr size_t WS_BBAR = WS_S5C + (size_t)64 * 64 * 8 * 4;
constexpr size_t WS_BAR = WS_BBAR + (size_t)64 * 64 * 32 * 4;
constexpr size_t WS_CNT = WS_BAR + 16384;
constexpr size_t WS_XBUF = WS_CNT + 16384;
constexpr size_t WS_STATS = WS_XBUF + (size_t)64 * 256 * 4 * 8;
constexpr size_t WS_END = WS_STATS + (size_t)MP * 8;

constexpr size_t O_Y = 0;
constexpr size_t O_S5RE_P = (size_t)MT * 1024;
constexpr size_t O_S5IM_P = O_S5RE_P + 8 * 64 * 64;
constexpr size_t O_S5RE_S = O_S5IM_P + 8 * 64 * 64;
constexpr size_t O_S5IM_S = O_S5RE_S + 128 * 64 * 64;
constexpr size_t O_CONV_P = O_S5IM_S + 128 * 64 * 64;
constexpr size_t O_CONV_S = O_CONV_P + 8 * 2 * 1024;
constexpr size_t O_FFN_P = O_CONV_S + 128 * 2 * 1024;
constexpr size_t O_FFN_S = O_FFN_P + (size_t)2 * 8 * 2 * 5632;
constexpr size_t O_END = O_FFN_S + (size_t)2 * 128 * 2 * 5632;

struct Params {
    const float *x_p, *x_s, *c_p, *c_s, *s5re, *s5im, *st_conv, *st_ffn, *w_ada, *b_ada, *s5_w_in, *lam_re, *lam_im, *log_dt,
        *b_re, *b_im, *c_re, *c_im, *s5_d, *w_glu, *sc_w_in, *sc_conv_w, *sc_w_out, *ffn_w_up, *ffn_conv_w, *ffn_conv_b, *ffn_w_down, *ln_g, *ln_b;
    float* out; unsigned char* ws; int ph_lo, ph_hi;
};
typedef const Params __attribute__((address_space(4))) KP;
__device__ __forceinline__ KP& getP() { KP* p = (KP*)__builtin_amdgcn_kernarg_segment_ptr(); asm volatile("" : "+s"(p)); return *p; }

__device__ __forceinline__ unsigned cvt_pk_bf16(float lo, float hi) { unsigned r; asm volatile("v_cvt_pk_bf16_f32 %0, %1, %2" : "=v"(r) : "v"(lo), "v"(hi)); return r; }
__device__ __forceinline__ float bf2f(unsigned short b) { return __uint_as_float(((unsigned)b) << 16); }
__device__ __forceinline__ float bflo(unsigned w) { return __uint_as_float(w << 16); }
__device__ __forceinline__ float bfhi(unsigned w) { return __uint_as_float(w & 0xffff0000u); }
__device__ __forceinline__ float sigmoidf_(float x) { return __builtin_amdgcn_rcpf(1.0f + __builtin_amdgcn_exp2f(-1.44269504089f * x)); }
__device__ __forceinline__ float gelu_tanh(float x) { const float u = 1.5957691216057308f * (x + 0.044715f * x * x * x); return x * sigmoidf_(u); }
typedef float f32x2 __attribute__((ext_vector_type(2)));
__device__ __forceinline__ f32x2 gelu2(f32x2 x) {
    f32x2 z = x * (x * x * (-0.10294324f) + (-2.302208198f));
    z.x = fminf(z.x, 60.f); z.y = fminf(z.y, 60.f);
    f32x2 d; d.x = __builtin_amdgcn_exp2f(z.x); d.y = __builtin_amdgcn_exp2f(z.y); d = d + 1.0f;
    const float r = __builtin_amdgcn_rcpf(d.x * d.y);
    return x * ((f32x2){d.y, d.x} * r);
}
__device__ __forceinline__ int pcol(int c) { return ((c >> 7) << 8) + (c & 127); }
template <int CTRL> __device__ __forceinline__ float dppx(float x) { return __builtin_bit_cast(float, __builtin_amdgcn_update_dpp(0, __builtin_bit_cast(int, x), CTRL, 0xf, 0xf, false)); }
__device__ __forceinline__ float wave_sum(float v) {
    v += dppx<0xB1>(v); v += dppx<0x4E>(v); v += dppx<0x141>(v); v += dppx<0x140>(v);
    v += __shfl_xor(v, 16); v += __shfl_xor(v, 32);
    return v;
}
template <int CTRL> __device__ __forceinline__ float dppf(float x) { return __builtin_bit_cast(float, __builtin_amdgcn_update_dpp(0, __builtin_bit_cast(int, x), CTRL, 0xf, 0xf, false)); }

extern __shared__ __attribute__((aligned(16))) unsigned char lds_raw[];
constexpr int LDS_WTAB = 131072 + 256;
__device__ __forceinline__ int ltid() {
    const unsigned slot = (unsigned)__builtin_amdgcn_s_getreg((5 << 11) | 4) & 63u;
    const int w = __builtin_amdgcn_readfirstlane(((volatile LAS int*)((LAS unsigned char*)lds_raw + LDS_WTAB))[slot]);
    int ln_; asm volatile("v_mbcnt_lo_u32_b32 %0, -1, 0\n\tv_mbcnt_hi_u32_b32 %0, -1, %0" : "=v"(ln_));
    int t = (w << 6) | ln_;
    asm volatile("" : "+v"(t));
    return t;
}
__device__ __forceinline__ void cis_d(double x, double& s, double& c) {
    const double k = rint(x * 0.63661977236758134308);
    double r = fma(-k, 1.57079632679489655800e+00, x); r = fma(-k, 6.12323399573676603587e-17, r);
    const double r2 = r * r;
    const double sp = r * (1.0 + r2 * (-1.0 / 6.0 + r2 * (1.0 / 120.0 + r2 * (-1.0 / 5040.0 + r2 * (1.0 / 362880.0 + r2 * (-1.0 / 39916800.0 + r2 * (1.0 / 6227020800.0)))))));
    const double cp = 1.0 + r2 * (-0.5 + r2 * (1.0 / 24.0 + r2 * (-1.0 / 720.0 + r2 * (1.0 / 40320.0 + r2 * (-1.0 / 3628800.0 + r2 * (1.0 / 479001600.0 + r2 * (-1.0 / 87178291200.0)))))));
    const int q = ((int)k) & 3;
    s = (q == 0) ? sp : (q == 1) ? cp : (q == 2) ? -sp : -cp;
    c = (q == 0) ? cp : (q == 1) ? -sp : (q == 2) ? -cp : sp;
}
__device__ __forceinline__ void apow_d(KP& P, int g, int p, double e, double& ar, double& ai) {
    const double lr = (double)P.lam_re[g * 64 + p], li = (double)P.lam_im[g * 64 + p], dt = exp((double)P.log_dt[g]);
    const double mag = exp(e * lr * dt); double s, c; cis_d(e * li * dt, s, c); ar = mag * c; ai = mag * s;
}
__device__ __forceinline__ void bcoef_d(KP& P, int g, int p, double& cr, double& ci) {
    const double lr = (double)P.lam_re[g * 64 + p], li = (double)P.lam_im[g * 64 + p];
    double ar, ai; apow_d(P, g, p, 1.0, ar, ai);
    const double nr = ar - 1.0, ni = ai, den = lr * lr + li * li;
    cr = (nr * lr + ni * li) / den; ci = (ni * lr - nr * li) / den;
}

constexpr int BM = 256, BK = 64, HALF = 128, HTB = HALF * BK * 2, NXCD = 8, WGM = 4;
__device__ __forceinline__ int lds_byte(int r, int c) { const int st = (r >> 4) * 2 + (c >> 5), rr = r & 15, cc = c & 31, ob = rr * 64 + cc * 2; return st * 1024 + (ob ^ (((ob >> 9) & 1) << 5)); }
__device__ __forceinline__ void stage_rc(int b, int& R, int& C) { const int st = b / 1024, sb = b % 1024, swz = sb ^ (((sb >> 9) & 1) << 5); R = (st >> 1) * 16 + swz / 64; C = (st & 1) * 32 + (swz % 64) / 2; }
__device__ __forceinline__ int perm32(int rho) { const int n = rho >> 4, i = rho & 15; return 8 * (i >> 2) + 4 * n + (i & 3); }

struct Unit { int pm, pn; };
struct Gemm { const bf16_t* A; const bf16_t* Bt; int lda, ldb, K; };
struct StaticOrder {
    int nM, nN, nwg, G, c, wg;
    __device__ __forceinline__ void init(int M, int N, int G_, int c_) { nM = M / BM; nN = N / BM; nwg = nM * nN; G = G_; c = c_; wg = (nN == 8) ? 1 : (nN > 12 ? 2 : WGM); }
    __device__ __forceinline__ bool next(int i, Unit& u) const {
        const long L = (long)i * G + c; if (L >= nwg) return false;
        int wgid = (int)L; { const int q = nwg / NXCD, r = nwg % NXCD, xcd = wgid % NXCD, off = wgid / NXCD; wgid = (xcd < r ? xcd * (q + 1) : r * (q + 1) + (xcd - r) * q) + off; }
        const int nig = wg * nN, gid = wgid / nig, fm = gid * wg, gsz = (nM - fm) < wg ? (nM - fm) : wg;
        u.pm = fm + ((wgid % nig) % gsz); u.pn = (wgid % nig) / gsz; return true;
    }
};
struct OneUnit { Unit u; __device__ __forceinline__ bool next(int i, Unit& o) const { if (i) return false; o = u; return true; } };

template <class Epi, class Sched>
__device__ __forceinline__ void gemm_phase(LAS unsigned char* lds, const Gemm g, const Sched& S, Epi& E) {
    const int tid = ltid(), wid = __builtin_amdgcn_readfirstlane(tid >> 6), lane = tid & 63, wr = wid >> 2, wc = wid & 3, fr = lane & 15, fq = lane >> 4;
    const int K = g.K, nt = K / BK;
    unsigned voffA[2], voffB[2];
#pragma unroll
    for (int i = 0; i < 2; ++i) { int R, C; stage_rc(tid * 16 + i * 8192, R, C); const int Rb = Epi::PERM ? ((R & ~31) + perm32(R & 31)) : R; const int Ra = Epi::RPERM ? (R + 64 * (R >> 6)) : R;
        voffA[i] = (Epi::AMODE == 1) ? (unsigned)((C >> 4) * (MP * 16) + Ra * 16 + (C & 15)) * 2u : (unsigned)(Ra * g.lda + C) * 2u; voffB[i] = (unsigned)(Rb * g.ldb + C) * 2u; }
    const size_t kstep = (size_t)(BK * 2);
    const size_t kstepA = (Epi::AMODE == 1) ? (size_t)4 * MP * 16 * 2 : kstep;
    const size_t hstepA = (Epi::AMODE == 1) ? (size_t)128 * 16 * 2 : (size_t)(Epi::RPERM ? 64 : 128) * g.lda * 2, hstepB = (size_t)HALF * g.ldb * 2;
    const size_t tstepA = (Epi::AMODE == 1) ? (size_t)BM * 16 * 2 : (size_t)BM * g.lda * 2, tstepB = (size_t)BM * g.ldb * 2;
    const unsigned ldsw = (unsigned)wid * 1024u;
    const int aoff = lds_byte(wr * 64 + fr, fq * 8), boff = lds_byte(wc * 32 + fr, fq * 8);
#define PG8_SA(b, h) (((b) * 2 + (h)) * HTB)
#define PG8_SB(b, h) ((4 + (b) * 2 + (h)) * HTB)
#define PG8_STAGE(bufoff, gbase, voff) do { _Pragma("unroll") for (int _i = 0; _i < 2; ++_i) \
        __builtin_amdgcn_global_load_lds((const unsigned*)((const char*)(gbase) + (voff)[_i]), (LAS unsigned*)(lds + (bufoff) + ldsw + _i * 8192), 16, 0, 0); } while (0)
#define PG8_LDA(dst, b, h) do { _Pragma("unroll") for (int m = 0; m < 4; ++m) _Pragma("unroll") for (int k = 0; k < 2; ++k) dst[m][k] = *(const LAS bf16x8*)(lds + PG8_SA(b, h) + aoff + m * 2048 + k * 1024); } while (0)
#define PG8_LDB(dst, b, h) do { _Pragma("unroll") for (int n = 0; n < 2; ++n) _Pragma("unroll") for (int k = 0; k < 2; ++k) dst[n][k] = *(const LAS bf16x8*)(lds + PG8_SB(b, h) + boff + n * 2048 + k * 1024); } while (0)
#define PG8_MMA(ai, bj, At, Bt) do { __builtin_amdgcn_s_setprio(1); _Pragma("unroll") for (int m = 0; m < 4; ++m) _Pragma("unroll") for (int n = 0; n < 2; ++n) _Pragma("unroll") for (int k = 0; k < 2; ++k) \
        acc[ai][bj][m][n] = __builtin_amdgcn_mfma_f32_16x16x32_bf16(Bt[n][k], At[m][k], acc[ai][bj][m][n], 0, 0, 0); __builtin_amdgcn_s_setprio(0); } while (0)
#define PG8_WAIT_V(n) asm volatile("s_waitcnt vmcnt(" #n ")" ::: "memory")
#define PG8_WAIT_L(n) asm volatile("s_waitcnt lgkmcnt(" #n ")" ::: "memory")
#define PG8_BAR __builtin_amdgcn_s_barrier()
#define PG8_SCHED __builtin_amdgcn_sched_barrier(0)
    Unit cur, nxt; int ui = 0;
    if (!S.next(0, cur)) return;
    f32x4 acc[2][2][4][2];
#pragma unroll
    for (int a = 0; a < 2; ++a)
#pragma unroll
        for (int b = 0; b < 2; ++b)
#pragma unroll
            for (int m = 0; m < 4; ++m)
#pragma unroll
                for (int n = 0; n < 2; ++n) acc[a][b][m][n] = (f32x4){0.f, 0.f, 0.f, 0.f};
    bf16x8 At[4][2], B0[2][2], B1[2][2];
    const char* cA = (const char*)g.A + (size_t)cur.pm * tstepA; const char* cB = (const char*)g.Bt + (size_t)cur.pn * tstepB;
    PG8_STAGE(PG8_SB(0, 0), cB, voffB); PG8_STAGE(PG8_SA(0, 0), cA, voffA); PG8_STAGE(PG8_SB(0, 1), cB + hstepB, voffB); PG8_STAGE(PG8_SA(0, 1), cA + hstepA, voffA);
    if (wr == 1) PG8_BAR;
    PG8_WAIT_V(4); PG8_BAR;
    PG8_STAGE(PG8_SB(1, 0), cB + kstep, voffB); PG8_STAGE(PG8_SA(1, 0), cA + kstepA, voffA); PG8_STAGE(PG8_SB(1, 1), cB + hstepB + kstep, voffB);
    PG8_WAIT_V(6); PG8_BAR;
    for (;;) {
        const bool has_next = S.next(ui + 1, nxt);
        const char* nA = has_next ? (const char*)g.A + (size_t)nxt.pm * tstepA : cA; const char* nB = has_next ? (const char*)g.Bt + (size_t)nxt.pn * tstepB : cB;
        for (int t = 0; t < nt; t += 2) {
            const bool last = (t == nt - 2);
            const char* a1 = cA + (size_t)(t + 1) * kstepA;
            const char* a2 = last ? nA : cA + (size_t)(t + 2) * kstepA; const char* b2 = last ? nB : cB + (size_t)(t + 2) * kstep;
            const char* a3 = a2 + kstepA; const char* b3 = b2 + kstep;
            PG8_LDB(B0, 0, 0); PG8_SCHED; PG8_LDA(At, 0, 0); PG8_STAGE(PG8_SA(1, 1), a1 + hstepA, voffA);
            PG8_WAIT_L(8); PG8_BAR; PG8_WAIT_L(0); PG8_MMA(0, 0, At, B0); PG8_BAR; PG8_SCHED;
            PG8_LDB(B1, 0, 1); PG8_STAGE(PG8_SB(0, 0), b2, voffB);
            PG8_BAR; PG8_WAIT_L(0); PG8_MMA(0, 1, At, B1); PG8_BAR;
            PG8_LDA(At, 0, 1); PG8_STAGE(PG8_SA(0, 0), a2, voffA);
            PG8_BAR; PG8_WAIT_L(0); PG8_MMA(1, 0, At, B0); PG8_BAR; PG8_SCHED;
            PG8_STAGE(PG8_SB(0, 1), b2 + hstepB, voffB);
            PG8_WAIT_V(6); PG8_BAR; PG8_MMA(1, 1, At, B1); PG8_BAR;
            PG8_LDB(B0, 1, 0); PG8_SCHED; PG8_LDA(At, 1, 0); PG8_STAGE(PG8_SA(0, 1), a2 + hstepA, voffA);
            PG8_WAIT_L(8); PG8_BAR; PG8_WAIT_L(0); PG8_MMA(0, 0, At, B0); PG8_BAR; PG8_SCHED;
            PG8_LDB(B1, 1, 1); PG8_STAGE(PG8_SB(1, 0), b3, voffB);
            PG8_BAR; PG8_WAIT_L(0); PG8_MMA(0, 1, At, B1); PG8_BAR;
            PG8_LDA(At, 1, 1); PG8_STAGE(PG8_SA(1, 0), a3, voffA);
            PG8_BAR; PG8_WAIT_L(0); PG8_MMA(1, 0, At, B0); PG8_BAR; PG8_SCHED;
            PG8_STAGE(PG8_SB(1, 1), b3 + hstepB, voffB);
            PG8_WAIT_V(6); PG8_BAR; PG8_MMA(1, 1, At, B1); PG8_BAR;
        }
        if constexpr (!Epi::AFTER_DRAIN) E(acc, cur, wr, wc, fr, fq);
        if (!has_next) break;
#pragma unroll
        for (int a = 0; a < 2; ++a)
#pragma unroll
            for (int b = 0; b < 2; ++b)
#pragma unroll
                for (int m = 0; m < 4; ++m)
#pragma unroll
                    for (int n = 0; n < 2; ++n) acc[a][b][m][n] = (f32x4){0.f, 0.f, 0.f, 0.f};
        cur = nxt; cA = nA; cB = nB; ++ui;
    }
    PG8_WAIT_V(0);
    if (wr == 0) PG8_BAR;
    PG8_BAR;
    if constexpr (Epi::AFTER_DRAIN) E.fused(acc, cur, wr, wc, fr, fq, lds, wid, lane);
#undef PG8_SA
#undef PG8_SB
#undef PG8_STAGE
#undef PG8_LDA
#undef PG8_LDB
#undef PG8_MMA
#undef PG8_WAIT_V
#undef PG8_WAIT_L
#undef PG8_BAR
#undef PG8_SCHED
}

typedef f32x4 AccT[2][2][4][2];
__device__ __forceinline__ u32x4 pack8(const f32x4 a, const f32x4 b) { u32x4 w; w.x = cvt_pk_bf16(a[0], a[1]); w.y = cvt_pk_bf16(a[2], a[3]); w.z = cvt_pk_bf16(b[0], b[1]); w.w = cvt_pk_bf16(b[2], b[3]); return w; }

struct EpiWin {
    static constexpr bool PERM = true, RPERM = false, AFTER_DRAIN = false; static constexpr int AMODE = 0;
    bf16_t* A2;
    __device__ __forceinline__ void operator()(AccT& acc, const Unit& u, int wr, int wc, int fr, int fq) const {
#pragma unroll
        for (int ai = 0; ai < 2; ++ai)
#pragma unroll
            for (int m = 0; m < 4; ++m) { const int rc = u.pm * 16 + ai * 8 + wr * 4 + m;
#pragma unroll
                for (int bj = 0; bj < 2; ++bj) { const int colb = u.pn * 256 + bj * 128 + wc * 32 + 8 * fq, g = colb >> 4, c0 = colb & 15;
                    *(u32x4*)(A2 + ((size_t)(g * 1024 + rc) * 384 + fr * 16 + c0)) = pack8(acc[ai][bj][m][0], acc[ai][bj][m][1]); }
                asm volatile("" ::: "memory"); }
    }
};
struct EpiS1 {
    static constexpr bool PERM = false, RPERM = false, AFTER_DRAIN = false; static constexpr int AMODE = 0;
    float* Sl;
    __device__ __forceinline__ void operator()(AccT& acc, const Unit& u, int wr, int wc, int fr, int fq) const {
#pragma unroll
        for (int ai = 0; ai < 2; ++ai)
#pragma unroll
            for (int m = 0; m < 4; ++m) { const int row = u.pm * 256 + ai * 128 + wr * 64 + m * 16 + fr;
#pragma unroll
                for (int n = 0; n < 2; ++n) *(f32x4*)(Sl + (size_t)row * 128 + wc * 32 + n * 16 + 4 * fq) = acc[ai][0][m][n]; }
    }
};
struct EpiS2 {
    static constexpr bool PERM = true, RPERM = false, AFTER_DRAIN = false; static constexpr int AMODE = 0;
    const bf16_t* A2g; const float* dsk; bf16_t* hA; int g;
    __device__ __forceinline__ void operator()(AccT& acc, const Unit& u, int wr, int wc, int fr, int fq) const {
        const int colb = wc * 32 + 8 * fq, rcb = u.pm * 256 + wr * 64 + fr;
        f32x4 d[2][2];
#pragma unroll
        for (int bj = 0; bj < 2; ++bj) { const int c0 = (bj * 128 + colb) & 15; d[bj][0] = *(const f32x4*)(dsk + g * 16 + c0); d[bj][1] = *(const f32x4*)(dsk + g * 16 + c0 + 4); }
        u32x4 uw[2];
        uw[0] = *(const u32x4*)(A2g + (size_t)rcb * 384 + colb);
#pragma unroll
        for (int st = 0; st < 16; ++st) { const int bj = st >> 3, ai = (st >> 2) & 1, m = st & 3;
            if (st + 1 < 16) { const int nb = (st + 1) >> 3, na = ((st + 1) >> 2) & 1, nm = (st + 1) & 3; uw[(st + 1) & 1] = *(const u32x4*)(A2g + (size_t)(rcb + na * 128 + nm * 16) * 384 + nb * 128 + colb); }
            asm volatile("" ::: "memory");
            const int col = bj * 128 + colb, l = col >> 4, c0 = col & 15, rc = rcb + ai * 128 + m * 16; const u32x4 w = uw[st & 1];
            f32x4 a = acc[ai][bj][m][0], b = acc[ai][bj][m][1];
            a[0] += d[bj][0][0] * bflo(w.x); a[1] += d[bj][0][1] * bfhi(w.x); a[2] += d[bj][0][2] * bflo(w.y); a[3] += d[bj][0][3] * bfhi(w.y);
            b[0] += d[bj][1][0] * bflo(w.z); b[1] += d[bj][1][1] * bfhi(w.z); b[2] += d[bj][1][2] * bflo(w.w); b[3] += d[bj][1][3] * bfhi(w.w);
#pragma unroll
            for (int j = 0; j < 4; j += 2) { const f32x2 ga = gelu2((f32x2){a[j], a[j + 1]}), gb = gelu2((f32x2){b[j], b[j + 1]}); a[j] = ga.x; a[j + 1] = ga.y; b[j] = gb.x; b[j + 1] = gb.y; }
            u32x4 o = pack8(a, b); asm volatile("" : "+v"(o));
            *(u32x4*)(hA + ((size_t)g * MP + rc * 16 + l) * 16 + c0) = o; }
    }
};

struct EpiGlu {
    static constexpr bool PERM = false, RPERM = false, AFTER_DRAIN = false; static constexpr int AMODE = 1;
    const float* xres; const float* gmod; bf16_t* T;
    __device__ __forceinline__ void operator()(AccT& acc, const Unit& u, int wr, int wc, int fr, int fq) const {
        const int ns = u.pm >> 3, colb = u.pn * 128 + wc * 32 + 4 * fq, rowb = u.pm * 256 + wr * 64 + fr;
        f32x4 gm[2], xr[2][2];
#pragma unroll
        for (int n = 0; n < 2; ++n) { gm[n] = *(const f32x4*)(gmod + (size_t)ns * NMOD + colb + n * 16); xr[0][n] = *(const f32x4*)(xres + (size_t)rowb * 1024 + colb + n * 16); }
#pragma unroll
        for (int st = 0; st < 8; ++st) { const int ai = st >> 2, m = st & 3, row = rowb + ai * 128 + m * 16;
            if (st + 1 < 8) { const int nrow = rowb + ((st + 1) >> 2) * 128 + ((st + 1) & 3) * 16;
#pragma unroll
                for (int n = 0; n < 2; ++n) xr[(st + 1) & 1][n] = *(const f32x4*)(xres + (size_t)nrow * 1024 + colb + n * 16); }
            asm volatile("" ::: "memory");
#pragma unroll
            for (int n = 0; n < 2; ++n) { const f32x4 v = acc[ai][0][m][n], gt = acc[ai][1][m][n], x = xr[st & 1][n]; f32x4 o;
#pragma unroll
                for (int j = 0; j < 4; ++j) o[j] = ALPHA * x[j] + gm[n][j] * (v[j] * sigmoidf_(gt[j]));
                u32x2 w; w.x = cvt_pk_bf16(o[0], o[1]); w.y = cvt_pk_bf16(o[2], o[3]); asm volatile("" : "+v"(w));
                *(u32x2*)(T + (size_t)row * 1024 + colb + n * 16) = w; } }
    }
};

struct EpiT {
    static constexpr bool PERM = false, RPERM = false, AFTER_DRAIN = false; static constexpr int AMODE = 0;
    const float* xres; const float* gmod; float* T;
    __device__ __forceinline__ void operator()(AccT& acc, const Unit& u, int wr, int wc, int fr, int fq) const {
#pragma unroll
        for (int ai = 0; ai < 2; ++ai)
#pragma unroll
            for (int m = 0; m < 4; ++m) { const int row = u.pm * 256 + ai * 128 + wr * 64 + m * 16 + fr; const int ns = row >> 11;
#pragma unroll
                for (int bj = 0; bj < 2; ++bj)
#pragma unroll
                    for (int n = 0; n < 2; ++n) { const int col = u.pn * 256 + bj * 128 + wc * 32 + n * 16 + 4 * fq;
                        const f32x4 xr = *(const f32x4*)(xres + (size_t)row * 1024 + col), gm = *(const f32x4*)(gmod + (size_t)ns * NMOD + col);
                        *(f32x4*)(T + (size_t)row * 1024 + col) = ALPHA * xr + gm * acc[ai][bj][m][n]; }
                asm volatile("" ::: "memory"); }
    }
};
struct EpiGateB {
    static constexpr bool PERM = true, RPERM = false, AFTER_DRAIN = false; static constexpr int AMODE = 0;
    bf16_t* z2;
    __device__ __forceinline__ void operator()(AccT& acc, const Unit& u, int wr, int wc, int fr, int fq) const {
#pragma unroll
        for (int ai = 0; ai < 2; ++ai)
#pragma unroll
            for (int m = 0; m < 4; ++m) { const int row = u.pm * 256 + ai * 128 + wr * 64 + m * 16 + fr;
#pragma unroll
                for (int bj = 0; bj < 2; ++bj) *(u32x4*)(z2 + (size_t)row * 2048 + u.pn * 256 + bj * 128 + wc * 32 + 8 * fq) = pack8(acc[ai][bj][m][0], acc[ai][bj][m][1]);
                asm volatile("" ::: "memory"); }
    }
};
struct EpiCv {
    static constexpr bool PERM = true, RPERM = false, AFTER_DRAIN = false; static constexpr int AMODE = 0;
    bf16_t* z2;
    __device__ __forceinline__ void operator()(AccT& acc, const Unit& u, int wr, int wc, int fr, int fq) const {
#pragma unroll
        for (int ai = 0; ai < 2; ++ai)
#pragma unroll
            for (int m = 0; m < 4; ++m) { const int row = u.pm * 256 + ai * 128 + wr * 64 + m * 16 + fr;
                *(u32x4*)(z2 + (size_t)row * 2048 + 1024 + u.pn * 128 + wc * 32 + 8 * fq) = pack8(acc[ai][0][m][0] * acc[ai][1][m][0], acc[ai][0][m][1] * acc[ai][1][m][1]);
                asm volatile("" ::: "memory"); }
    }
};
struct EpiUp {
    static constexpr bool PERM = true, RPERM = true, AFTER_DRAIN = false; static constexpr int AMODE = 0;
    bf16_t* act; bf16_t* halo; float* ffn_out; const float* cw; const float* cb;
    __device__ __forceinline__ void operator()(AccT& acc, const Unit& u, int wr, int wc, int fr, int fq) const {
        const int vcol = u.pn * 128 + wc * 32 + 8 * fq, blk = u.pm * 2 + wr;
        asm volatile("" ::: "memory"); __builtin_amdgcn_sched_barrier(0);
        if (fr < 2) {
#pragma unroll
            for (int bj = 0; bj < 2; ++bj) *(u32x4*)(halo + (size_t)(blk * 4 + fr) * DFF2 + bj * DFF + vcol) = pack8(acc[0][bj][0][0], acc[0][bj][0][1]);
        }
        if (fr >= 14) {
#pragma unroll
            for (int bj = 0; bj < 2; ++bj) { *(u32x4*)(halo + (size_t)(blk * 4 + 2 + (fr - 14)) * DFF2 + bj * DFF + vcol) = pack8(acc[1][bj][3][0], acc[1][bj][3][1]);
                if ((u.pm & 7) == 7 && wr == 1) { float* o = ffn_out + (size_t)((u.pm >> 3) * 2 + (fr - 14)) * DFF2 + bj * DFF + vcol; *(f32x4*)o = acc[1][bj][3][0]; *(f32x4*)(o + 4) = acc[1][bj][3][1]; } }
        }
        asm volatile("" ::: "memory"); __builtin_amdgcn_sched_barrier(0);
        f32x4 wq[2][4];
        { const int col = vcol; wq[0][0] = *(const f32x4*)(cw + col); wq[0][1] = *(const f32x4*)(cw + DFF2 + col); wq[0][2] = *(const f32x4*)(cw + 2 * DFF2 + col); wq[0][3] = *(const f32x4*)(cb + col); }
#pragma unroll
        for (int gi = 0; gi < 4; ++gi) { const int bj = gi >> 1, n = gi & 1;
            if (gi + 1 < 4) { const int col = ((gi + 1) >> 1) * DFF + vcol + 4 * ((gi + 1) & 1);
                wq[(gi + 1) & 1][0] = *(const f32x4*)(cw + col); wq[(gi + 1) & 1][1] = *(const f32x4*)(cw + DFF2 + col); wq[(gi + 1) & 1][2] = *(const f32x4*)(cw + 2 * DFF2 + col); wq[(gi + 1) & 1][3] = *(const f32x4*)(cb + col); }
            asm volatile("" ::: "memory");
            const f32x4 w0 = wq[gi & 1][0], w1 = wq[gi & 1][1], w2 = wq[gi & 1][2], bb = wq[gi & 1][3];
            f32x4 w1c, w1p, w0c, w0p;
#pragma unroll
            for (int j = 0; j < 4; ++j) { w1c[j] = (fr == 0) ? 0.f : w1[j]; w1p[j] = (fr == 0) ? w1[j] : 0.f; w0c[j] = (fr < 2) ? 0.f : w0[j]; w0p[j] = (fr < 2) ? w0[j] : 0.f; }
#pragma unroll
            for (int rg = 7; rg >= 0; --rg) { const int ai = rg >> 2, m = rg & 3, pi = (rg ? rg - 1 : 0) >> 2, pmm = (rg ? rg - 1 : 0) & 3;
                const f32x4 cur = acc[ai][bj][m][n], prev = acc[pi][bj][pmm][n]; f32x4 r;
#pragma unroll
                for (int j = 0; j < 4; ++j) { float t = w2[j] * cur[j] + bb[j];
                    asm volatile("s_nop 1\n\tv_fmac_f32_dpp %0, %1, %2 row_ror:1 row_mask:0xf bank_mask:0xf" : "+v"(t) : "v"(cur[j]), "v"(w1c[j]));
                    asm volatile("v_fmac_f32_dpp %0, %1, %2 row_ror:1 row_mask:0xf bank_mask:0xf" : "+v"(t) : "v"(prev[j]), "v"(w1p[j]));
                    asm volatile("v_fmac_f32_dpp %0, %1, %2 row_ror:2 row_mask:0xf bank_mask:0xf" : "+v"(t) : "v"(cur[j]), "v"(w0c[j]));
                    asm volatile("v_fmac_f32_dpp %0, %1, %2 row_ror:2 row_mask:0xf bank_mask:0xf" : "+v"(t) : "v"(prev[j]), "v"(w0p[j]));
                    r[j] = t; }
                acc[ai][bj][m][n] = r; } }
#pragma unroll
        for (int rg = 0; rg < 8; ++rg) { const int ai = rg >> 2, m = rg & 3; const int row = u.pm * 256 + wr * 128 + rg * 16 + fr;
            f32x4 a, b;
#pragma unroll
            for (int j = 0; j < 4; j += 2) { const f32x2 ga = gelu2((f32x2){acc[ai][1][m][0][j], acc[ai][1][m][0][j + 1]}), gb = gelu2((f32x2){acc[ai][1][m][1][j], acc[ai][1][m][1][j + 1]});
                a[j] = ga.x * acc[ai][0][m][0][j]; a[j + 1] = ga.y * acc[ai][0][m][0][j + 1]; b[j] = gb.x * acc[ai][0][m][1][j]; b[j + 1] = gb.y * acc[ai][0][m][1][j + 1]; }
            if (rg != 0 || fr >= 2) *(u32x4*)(act + (size_t)row * DFF + vcol) = pack8(a, b);
            asm volatile("" ::: "memory"); __builtin_amdgcn_sched_barrier(0); }
    }
};

template <int XIN, bool XOUT_F32> struct EpiLnT {
    static constexpr bool XREC = (XIN == 1); const bf16_t* xbi; bf16_t* xbo;
    static constexpr bool PERM = false, RPERM = false, AFTER_DRAIN = true; static constexpr int AMODE = 0;
    const bf16_t* Tb; const float* stats; const float* lg0; const float* lb0;
    const float* xres; const float* mods; int gate_off, next_off; const float* lg; const float* lb; float* xout; bf16_t* hA; unsigned long long* xbuf; unsigned* cnt;
    __device__ __forceinline__ void fused(AccT& acc, const Unit& u, int wr, int wc, int fr, int fq, LAS unsigned char* lds, int wid, int lane) const {
        typedef float f32x2v __attribute__((ext_vector_type(2)));
        const int ns = u.pm >> 3, tid = wid * 64 + lane;
        LAS f32x2v* Pt = (LAS f32x2v*)lds;
        LAS f32x2v* St = (LAS f32x2v*)(lds + 8192);
        if constexpr (XIN == 0) {
            const int colb = u.pn * 256 + wc * 32 + 4 * fq, rowb = u.pm * 256 + wr * 64 + fr;
            f32x4 gm[2][2], xr[2][2][2];
#pragma unroll
            for (int bj = 0; bj < 2; ++bj)
#pragma unroll
                for (int n = 0; n < 2; ++n) { gm[bj][n] = *(const f32x4*)(mods + (size_t)ns * NMOD + gate_off + colb + bj * 128 + n * 16); xr[0][bj][n] = *(const f32x4*)(xres + (size_t)rowb * 1024 + colb + bj * 128 + n * 16); }
#pragma unroll
            for (int st = 0; st < 8; ++st) { const int ai = st >> 2, m = st & 3;
                if (st + 1 < 8) { const int nrow = rowb + ((st + 1) >> 2) * 128 + ((st + 1) & 3) * 16;
#pragma unroll
                    for (int bj = 0; bj < 2; ++bj)
#pragma unroll
                        for (int n = 0; n < 2; ++n) xr[(st + 1) & 1][bj][n] = *(const f32x4*)(xres + (size_t)nrow * 1024 + colb + bj * 128 + n * 16); }
                asm volatile("" ::: "memory");
#pragma unroll
                for (int bj = 0; bj < 2; ++bj)
#pragma unroll
                    for (int n = 0; n < 2; ++n) acc[ai][bj][m][n] = ALPHA * xr[st & 1][bj][n] + gm[bj][n] * acc[ai][bj][m][n];
                asm volatile("" : "+v"(acc[ai][0][m][0]), "+v"(acc[ai][0][m][1]), "+v"(acc[ai][1][m][0]), "+v"(acc[ai][1][m][1])); }
        } else if constexpr (XIN == 2) {
            const int colb = u.pn * 256 + wc * 32 + 4 * fq, rowb = u.pm * 256 + wr * 64 + fr;
            f32x4 gm[2][2]; u32x2 xr[2][2][2];
#pragma unroll
            for (int bj = 0; bj < 2; ++bj)
#pragma unroll
                for (int n = 0; n < 2; ++n) { gm[bj][n] = *(const f32x4*)(mods + (size_t)ns * NMOD + gate_off + colb + bj * 128 + n * 16); xr[0][bj][n] = *(const u32x2*)(xbi + (size_t)rowb * 1024 + colb + bj * 128 + n * 16); }
#pragma unroll
            for (int st = 0; st < 8; ++st) { const int ai = st >> 2, m = st & 3;
                if (st + 1 < 8) { const int nrow = rowb + ((st + 1) >> 2) * 128 + ((st + 1) & 3) * 16;
#pragma unroll
                    for (int bj = 0; bj < 2; ++bj)
#pragma unroll
                        for (int n = 0; n < 2; ++n) xr[(st + 1) & 1][bj][n] = *(const u32x2*)(xbi + (size_t)nrow * 1024 + colb + bj * 128 + n * 16); }
                asm volatile("" ::: "memory");
#pragma unroll
                for (int bj = 0; bj < 2; ++bj)
#pragma unroll
                    for (int n = 0; n < 2; ++n) { const u32x2 w = xr[st & 1][bj][n]; acc[ai][bj][m][n] = ALPHA * (f32x4){bflo(w.x), bfhi(w.x), bflo(w.y), bfhi(w.y)} + gm[bj][n] * acc[ai][bj][m][n]; }
                asm volatile("" : "+v"(acc[ai][0][m][0]), "+v"(acc[ai][0][m][1]), "+v"(acc[ai][1][m][0]), "+v"(acc[ai][1][m][1])); }
        } else {
            const int colb = u.pn * 256 + wc * 32 + 4 * fq, rowb = u.pm * 256 + wr * 64 + fr;
            f32x4 gm[2][2], g0[2][2], b0[2][2]; u32x2 tb[2][2][2]; f32x2v sr[2];
#pragma unroll
            for (int bj = 0; bj < 2; ++bj)
#pragma unroll
                for (int n = 0; n < 2; ++n) { const int col = colb + bj * 128 + n * 16; gm[bj][n] = *(const f32x4*)(mods + (size_t)ns * NMOD + gate_off + col);
                    g0[bj][n] = *(const f32x4*)(lg0 + col); b0[bj][n] = *(const f32x4*)(lb0 + col); tb[0][bj][n] = *(const u32x2*)(Tb + (size_t)rowb * 1024 + col); }
            sr[0] = *(const f32x2v*)(stats + (size_t)rowb * 2);
#pragma unroll
            for (int st = 0; st < 8; ++st) { const int ai = st >> 2, m = st & 3;
                if (st + 1 < 8) { const int nrow = rowb + ((st + 1) >> 2) * 128 + ((st + 1) & 3) * 16; sr[(st + 1) & 1] = *(const f32x2v*)(stats + (size_t)nrow * 2);
#pragma unroll
                    for (int bj = 0; bj < 2; ++bj)
#pragma unroll
                        for (int n = 0; n < 2; ++n) tb[(st + 1) & 1][bj][n] = *(const u32x2*)(Tb + (size_t)nrow * 1024 + colb + bj * 128 + n * 16); }
                asm volatile("" ::: "memory");
                const float mean = sr[st & 1].x, rstd = sr[st & 1].y;
#pragma unroll
                for (int bj = 0; bj < 2; ++bj)
#pragma unroll
                    for (int n = 0; n < 2; ++n) { const u32x2 w = tb[st & 1][bj][n]; const f32x4 t = (f32x4){bflo(w.x), bfhi(w.x), bflo(w.y), bfhi(w.y)};
                        const f32x4 x = (t - mean) * rstd * g0[bj][n] + b0[bj][n];
                        acc[ai][bj][m][n] = ALPHA * x + gm[bj][n] * acc[ai][bj][m][n]; }
                asm volatile("" : "+v"(acc[ai][0][m][0]), "+v"(acc[ai][0][m][1]), "+v"(acc[ai][1][m][0]), "+v"(acc[ai][1][m][1])); }
        }
#pragma unroll
        for (int ai = 0; ai < 2; ++ai)
#pragma unroll
            for (int m = 0; m < 4; ++m) { float s_ = 0.f, q_ = 0.f;
#pragma unroll
                for (int bj = 0; bj < 2; ++bj)
#pragma unroll
                    for (int n = 0; n < 2; ++n) { const f32x4 x = acc[ai][bj][m][n]; s_ += (x[0] + x[1]) + (x[2] + x[3]); q_ += (x[0] * x[0] + x[1] * x[1]) + (x[2] * x[2] + x[3] * x[3]); }
                s_ += __shfl_xor(s_, 16); s_ += __shfl_xor(s_, 32); q_ += __shfl_xor(q_, 16); q_ += __shfl_xor(q_, 32);
                if (fq == 0) Pt[(ai * 128 + wr * 64 + m * 16 + fr) * 4 + wc] = (f32x2v){s_, q_}; }
        __syncthreads();
        if (tid < 256) { const f32x2v a = Pt[tid * 4 + 0], b = Pt[tid * 4 + 1], c = Pt[tid * 4 + 2], d = Pt[tid * 4 + 3];
            const float S = (a.x + b.x) + (c.x + d.x), Q = (a.y + b.y) + (c.y + d.y);
            __hip_atomic_store(xbuf + ((size_t)(u.pm * 256 + tid) * 4 + u.pn), ((unsigned long long)__float_as_uint(Q) << 32) | __float_as_uint(S), __ATOMIC_RELAXED, __HIP_MEMORY_SCOPE_AGENT); }
        asm volatile("s_waitcnt vmcnt(0)" ::: "memory");
        if (tid < 256 && lane == 0) __hip_atomic_fetch_add(cnt + 16 * u.pm, 1u, __ATOMIC_RELAXED, __HIP_MEMORY_SCOPE_AGENT);
        if (wid == 0) { unsigned spins = 0;
            while ((unsigned)__builtin_amdgcn_readfirstlane(__hip_atomic_load(cnt + 16 * u.pm, __ATOMIC_RELAXED, __HIP_MEMORY_SCOPE_AGENT)) < 16u) { __builtin_amdgcn_s_sleep(1); if (++spins > (1u << 22)) break; }
            __builtin_amdgcn_fence(__ATOMIC_ACQUIRE, "agent"); asm volatile("s_waitcnt vmcnt(0)" ::: "memory"); }
        __syncthreads();
        if (tid < 256) { const unsigned long long* sl = xbuf + (size_t)(u.pm * 256 + tid) * 4; float S = 0.f, Q = 0.f;
#pragma unroll
            for (int t = 0; t < 4; ++t) { const unsigned long long w = __hip_atomic_load(sl + t, __ATOMIC_RELAXED, __HIP_MEMORY_SCOPE_AGENT); S += __uint_as_float((unsigned)w); Q += __uint_as_float((unsigned)(w >> 32)); }
            const float mean = S * (1.0f / 1024.0f), var = fmaxf(Q * (1.0f / 1024.0f) - mean * mean, 0.f);
            St[tid] = (f32x2v){mean, 1.0f / sqrtf(var + LN_EPS)}; }
        __syncthreads();
#pragma unroll
        for (int bj = 0; bj < 2; ++bj)
#pragma unroll
            for (int n = 0; n < 2; ++n) { const int col = u.pn * 256 + bj * 128 + wc * 32 + n * 16 + 4 * fq;
                const f32x4 gg = *(const f32x4*)(lg + col), bb = *(const f32x4*)(lb + col);
                f32x4 sh = (f32x4){0.f, 0.f, 0.f, 0.f}, sc = sh;
                if (next_off >= 0) { sh = *(const f32x4*)(mods + (size_t)ns * NMOD + next_off + col); sc = *(const f32x4*)(mods + (size_t)ns * NMOD + next_off + 1024 + col); }
#pragma unroll
                for (int ai = 0; ai < 2; ++ai)
#pragma unroll
                    for (int m = 0; m < 4; ++m) { const int rl = ai * 128 + wr * 64 + m * 16 + fr; const f32x2v st = St[rl]; const size_t off = (size_t)(u.pm * 256 + rl) * 1024 + col;
                        const f32x4 xn = (acc[ai][bj][m][n] - st.x) * st.y * gg + bb;
                        if constexpr (XOUT_F32) *(f32x4*)(xout + off) = xn; else { u32x2 xw; xw.x = cvt_pk_bf16(xn[0], xn[1]); xw.y = cvt_pk_bf16(xn[2], xn[3]); *(u32x2*)(xbo + off) = xw; }
                        if (next_off >= 0) { u32x2 w; w.x = cvt_pk_bf16(xn[0] * (1.f + sc[0]) + sh[0], xn[1] * (1.f + sc[1]) + sh[1]); w.y = cvt_pk_bf16(xn[2] * (1.f + sc[2]) + sh[2], xn[3] * (1.f + sc[3]) + sh[3]);
                            *(u32x2*)(hA + off) = w; } }
                asm volatile("" ::: "memory"); }
    }
};

template <int STEPS>
__device__ __forceinline__ void skinny_gemm(const bf16_t* A, int K, int nrb, int rows_valid, const bf16_t* Bt, int N, float* out, const float* bias, int ustart, int ustride) {
    const int tid = ltid(), wid = tid >> 6, lane = tid & 63, fr = lane & 15, fq = lane >> 4;
    const int KS = K / (32 * STEPS), ncb = N / 16, nunits = ncb * KS;
    for (int skr_ = 0; skr_ < SKREP; ++skr_)
    for (int u = ustart; u < nunits; u += ustride) {
        const int cb = u % ncb, ks = u / ncb, col0 = cb * 16, k0 = ks * 32 * STEPS;
        for (int rb = wid; rb < nrb; rb += 8) {
            const bf16_t* ap = A + (size_t)(rb * 16 + fr) * K + k0 + fq * 8; const bf16_t* bp = Bt + (size_t)(col0 + fr) * K + k0 + fq * 8;
            bf16x8 a[STEPS], b[STEPS];
#pragma unroll
            for (int i = 0; i < STEPS; ++i) { a[i] = *(const bf16x8*)(ap + 32 * i); b[i] = *(const bf16x8*)(bp + 32 * i); }
            f32x4 acc = (f32x4){0.f, 0.f, 0.f, 0.f};
#pragma unroll
            for (int i = 0; i < STEPS; ++i) acc = __builtin_amdgcn_mfma_f32_16x16x32_bf16(b[i], a[i], acc, 0, 0, 0);
            const int row = rb * 16 + fr;
            if (row < rows_valid) { const int c = col0 + fq * 4; if (bias) acc += *(const f32x4*)(bias + c);
                *(f32x4*)(out + ((size_t)ks * rows_valid + row) * N + c) = acc; }
        }
    }
}
__device__ __forceinline__ f32x4 rawsum4(const float* raw, size_t idx, int KS, size_t stride) { f32x4 v = *(const f32x4*)(raw + idx); for (int k = 1; k < KS; ++k) v += *(const f32x4*)(raw + k * stride + idx); return v; }
__device__ __forceinline__ float rawsum1(const float* raw, size_t idx, int KS, size_t stride) { float v = raw[idx]; for (int k = 1; k < KS; ++k) v += raw[k * stride + idx]; return v; }
__device__ __forceinline__ void skinny3(LAS float* sm, const bf16_t* A, int K, const bf16_t* Bt, int N, float* out, int ustart, int ustride) {
    const int tid = ltid(), wid = __builtin_amdgcn_readfirstlane(tid >> 6), lane = tid & 63, fr = lane & 15, fq = lane >> 4;
    const int nsteps = K / 256, ncb = N / 16;
    const unsigned loff = (unsigned)(fr * K + fq * 8);
    for (int skr_ = 0; skr_ < SKREP; ++skr_)
    for (int u = ustart; u < ncb; u += ustride) {
        const int col0 = u * 16;
        f32x4 acc[8];
#pragma unroll
        for (int rb = 0; rb < 8; ++rb) acc[rb] = (f32x4){0.f, 0.f, 0.f, 0.f};
        for (int s0 = 0; s0 < nsteps; s0 += 4) {
            const int cnt = nsteps - s0; const size_t ku = (size_t)(wid * nsteps + s0) * 32;
            const bf16_t* bu = Bt + (size_t)col0 * K + ku; const bf16_t* au = A + ku;
            bf16x8 b[4], a[8][4];
#pragma unroll
            for (int i = 0; i < 4; ++i) { const int ii = (i < cnt) ? i : 0; b[i] = *(const bf16x8*)(bu + 32 * ii + loff); }
#pragma unroll
            for (int rb = 0; rb < 8; ++rb)
#pragma unroll
                for (int i = 0; i < 4; ++i) { const int ii = (i < cnt) ? i : 0; a[rb][i] = *(const bf16x8*)(au + (size_t)rb * 16 * K + 32 * ii + loff); }
#pragma unroll
            for (int i = 0; i < 4; ++i) if (i >= cnt) b[i] = (bf16x8){0, 0, 0, 0, 0, 0, 0, 0};
#pragma unroll
            for (int rb = 0; rb < 8; ++rb)
#pragma unroll
                for (int i = 0; i < 4; ++i) acc[rb] = __builtin_amdgcn_mfma_f32_16x16x32_bf16(b[i], a[rb][i], acc[rb], 0, 0, 0);
        }
        __syncthreads();
#pragma unroll
        for (int rb = 0; rb < 8; ++rb) *(LAS f32x4*)(sm + ((wid * 8 + rb) * 16 + fr) * 16 + fq * 4) = acc[rb];
        __syncthreads();
        { const int row = tid >> 2, cq = tid & 3; f32x4 sum = (f32x4){0.f, 0.f, 0.f, 0.f};
#pragma unroll
            for (int w = 0; w < 8; ++w) sum += *(const LAS f32x4*)(sm + ((w * 8 + (row >> 4)) * 16 + (row & 15)) * 16 + cq * 4);
            *(f32x4*)(out + (size_t)row * N + col0 + cq * 4) = sum; }
    }
}
__device__ __forceinline__ void skinny_up(KP& P, int layer, LAS float* sm, const bf16_t* A, const bf16_t* Bt, int ustart, int ustride) {
    const int tid = ltid(), wid = __builtin_amdgcn_readfirstlane(tid >> 6), lane = tid & 63, fr = lane & 15, fq = lane >> 4;
    constexpr int K = 1024; const unsigned loff = (unsigned)(fr * K + fq * 8);
    const float* cw = P.ffn_conv_w + (size_t)layer * 3 * DFF2; const float* cb = P.ffn_conv_b + (size_t)layer * DFF2; bf16_t* act = (bf16_t*)(P.ws + WS_BIG);
    for (int u = ustart; u < DFF / 16; u += ustride) {
        const int c0 = u * 16, rv = pcol(c0); const size_t ku = (size_t)wid * 128;
        bf16x8 a[8][4], b[4]; f32x4 accv[8], accg[8];
#pragma unroll
        for (int rb = 0; rb < 8; ++rb)
#pragma unroll
            for (int i = 0; i < 4; ++i) a[rb][i] = *(const bf16x8*)(A + ku + (size_t)rb * 16 * K + 32 * i + loff);
#pragma unroll
        for (int i = 0; i < 4; ++i) b[i] = *(const bf16x8*)(Bt + (size_t)rv * K + ku + 32 * i + loff);
#pragma unroll
        for (int rb = 0; rb < 8; ++rb) { accv[rb] = (f32x4){0.f, 0.f, 0.f, 0.f};
#pragma unroll
            for (int i = 0; i < 4; ++i) accv[rb] = __builtin_amdgcn_mfma_f32_16x16x32_bf16(b[i], a[rb][i], accv[rb], 0, 0, 0); }
#pragma unroll
        for (int i = 0; i < 4; ++i) b[i] = *(const bf16x8*)(Bt + (size_t)(rv + 128) * K + ku + 32 * i + loff);
#pragma unroll
        for (int rb = 0; rb < 8; ++rb) { accg[rb] = (f32x4){0.f, 0.f, 0.f, 0.f};
#pragma unroll
            for (int i = 0; i < 4; ++i) accg[rb] = __builtin_amdgcn_mfma_f32_16x16x32_bf16(b[i], a[rb][i], accg[rb], 0, 0, 0); }
        __syncthreads();
#pragma unroll
        for (int rb = 0; rb < 8; ++rb) { *(LAS f32x4*)(sm + ((wid * 8 + rb) * 16 + fr) * 16 + fq * 4) = accv[rb]; *(LAS f32x4*)(sm + 16384 + ((wid * 8 + rb) * 16 + fr) * 16 + fq * 4) = accg[rb]; }
        __syncthreads();
        { const int row = tid >> 2, cq = tid & 3, c = c0 + cq * 4; f32x4 uv = (f32x4){0.f, 0.f, 0.f, 0.f}, ug = uv;
#pragma unroll
            for (int w = 0; w < 8; ++w) { uv += *(const LAS f32x4*)(sm + ((w * 8 + (row >> 4)) * 16 + (row & 15)) * 16 + cq * 4); ug += *(const LAS f32x4*)(sm + 16384 + ((w * 8 + (row >> 4)) * 16 + (row & 15)) * 16 + cq * 4); }
            const float* st = P.st_ffn + (size_t)(layer * NS + row) * 2 * DFF2; float* so = P.out + O_FFN_S + (size_t)(layer * NS + row) * 2 * DFF2;
            const f32x4 b0v = *(const f32x4*)(st + c), b1v = *(const f32x4*)(st + DFF2 + c), b0g = *(const f32x4*)(st + DFF + c), b1g = *(const f32x4*)(st + DFF2 + DFF + c);
            const f32x4 cv = *(const f32x4*)(cw + 2 * DFF2 + c) * uv + *(const f32x4*)(cw + DFF2 + c) * b1v + *(const f32x4*)(cw + c) * b0v + *(const f32x4*)(cb + c);
            const f32x4 cg_ = *(const f32x4*)(cw + 2 * DFF2 + DFF + c) * ug + *(const f32x4*)(cw + DFF2 + DFF + c) * b1g + *(const f32x4*)(cw + DFF + c) * b0g + *(const f32x4*)(cb + DFF + c);
            *(f32x4*)(so + c) = b1v; *(f32x4*)(so + DFF2 + c) = uv; *(f32x4*)(so + DFF + c) = b1g; *(f32x4*)(so + DFF2 + DFF + c) = ug;
            u32x2 w; w.x = cvt_pk_bf16(gelu_tanh(cg_[0]) * cv[0], gelu_tanh(cg_[1]) * cv[1]); w.y = cvt_pk_bf16(gelu_tanh(cg_[2]) * cv[2], gelu_tanh(cg_[3]) * cv[3]);
            *(u32x2*)(act + (size_t)(MP + row) * DFF + c) = w; }
    }
    __syncthreads();
}

struct TrD { const float* W; bf16_t* Bt; int K, Nsrc, mode, half, rb, kb; };
__device__ __forceinline__ bool tr_decode(KP& P, int it, TrD& d) {
    if (it < 0 || it >= 1504) return false;
    unsigned char* ws = P.ws; int i = it;
    if (i < 64) { d = TrD{P.s5_w_in, (bf16_t*)(ws + WS_WIN), 1024, 1024, 0, 0, i / 16, i % 16}; return true; } i -= 64;
    if (i < 128) { d = TrD{P.w_glu, (bf16_t*)(ws + WS_WGLU), 1024, 2048, 1, 1024, i / 16, i % 16}; return true; } i -= 128;
    if (i < 192) { d = TrD{P.sc_w_in, (bf16_t*)(ws + WS_SCIN), 1024, 3072, 2, 0, i / 16, i % 16}; return true; } i -= 192;
    if (i < 64) { d = TrD{P.sc_w_out, (bf16_t*)(ws + WS_SCOUT), 1024, 1024, 0, 0, i / 16, i % 16}; return true; } i -= 64;
    if (i < 704) { const int l = i / 352, j = i % 352; d = TrD{P.ffn_w_up + (size_t)l * 1024 * DFF2, (bf16_t*)(ws + WS_UP) + (size_t)l * DFF2 * 1024, 1024, DFF2, 1, DFF, j / 16, j % 16}; return true; } i -= 704;
    { const int l = i / 176, j = i % 176; d = TrD{P.ffn_w_down + (size_t)l * DFF * 1024, (bf16_t*)(ws + WS_DOWN) + (size_t)l * 1024 * DFF, DFF, 1024, 0, 0, j / 44, j % 44}; return true; }
}
__device__ __forceinline__ void tr_load(const TrD& d, int tid, f32x4 (&r)[8]) {
#pragma unroll
    for (int i = 0; i < 8; ++i) { const int idx4 = tid + NTHR * i, kr = idx4 >> 6, nc4 = (idx4 & 63) * 4, sb = nc4 >> 6, within = sb * 64;
        int src0;
        if (d.mode == 0) src0 = d.rb * 256 + within;
        else if (d.mode == 1) src0 = (within < 128) ? 128 * d.rb + within : d.half + 128 * d.rb + within - 128;
        else { if (d.rb < 4) src0 = d.rb * 256 + within; else { const int t = d.rb - 4; src0 = (within < 128) ? 1024 + 128 * t + within : 2048 + 128 * t + within - 128; } }
        r[i] = *(const f32x4*)(d.W + (size_t)(d.kb * 64 + kr) * d.Nsrc + src0 + (nc4 & 63)); }
}
__device__ __forceinline__ void tr_store(LAS float* sm, const TrD& d, int tid, const f32x4 (&r)[8]) {
    __syncthreads();
#pragma unroll
    for (int i = 0; i < 8; ++i) { const int idx4 = tid + NTHR * i, kr = idx4 >> 6, nc4 = (idx4 & 63) * 4; LAS float* q = sm + kr * 257 + nc4; q[0] = r[i][0]; q[1] = r[i][1]; q[2] = r[i][2]; q[3] = r[i][3]; }
    __syncthreads();
#pragma unroll
    for (int i = 0; i < 4; ++i) { const int np = (tid >> 3) + 64 * i, kp = tid & 7; float e[8];
#pragma unroll
        for (int q = 0; q < 8; ++q) e[q] = sm[(kp * 8 + q) * 257 + np];
        u32x4 w; w.x = cvt_pk_bf16(e[0], e[1]); w.y = cvt_pk_bf16(e[2], e[3]); w.z = cvt_pk_bf16(e[4], e[5]); w.w = cvt_pk_bf16(e[6], e[7]);
        *(u32x4*)(d.Bt + (size_t)(d.rb * 256 + np) * d.K + d.kb * 64 + kp * 8) = w; }
}
__device__ __forceinline__ int p0_item(int bx, int G, int k) {
    if (G != 256) return bx + G * k;
    return bx < 64 ? (k < 7 ? bx + 64 * k : -1) : 448 + (bx - 64) + 192 * k;
}
__device__ __forceinline__ void p0_convert(KP& P, LAS float* sm) {
    unsigned char* ws = P.ws; const int G = gridDim.x, bx = blockIdx.x, tid = ltid();
    int k = 0; TrD d, dn; f32x4 r[8], rn[8];
    bool v = tr_decode(P, p0_item(bx, G, 0), d);
    if (v) tr_load(d, tid, r);
    while (v) {
        ++k; const bool vn = tr_decode(P, p0_item(bx, G, k), dn);
        if (vn) tr_load(dn, tid, rn);
        tr_store(sm, d, tid, r);
        d = dn; v = vn;
#pragma unroll
        for (int i = 0; i < 8; ++i) r[i] = rn[i];
    }
}
__device__ __forceinline__ void mods_phase(KP& P, LAS float* sm, int ustart, int ustride) {
    const int tid = ltid(), wid = __builtin_amdgcn_readfirstlane(tid >> 6), lane = tid & 63, fr = lane & 15, fq = lane >> 4;
    float* mods = (float*)(P.ws + WS_MODS);
    const int ct = wid & 3, rb0 = wid >> 2; constexpr int PITCH = 65, BUF = 128 * PITCH, APITCH = 136;
    LAS bf16_t* sA = (LAS bf16_t*)(sm + 2 * BUF);
    auto ldc = [&](int ch, f32x4 (&cv)[9]) {
#pragma unroll
        for (int i = 0; i < 9; ++i) { const int e = tid + NTHR * i, row = e >> 5, k = ch * 128 + (e & 31) * 4;
            cv[i] = (f32x4){0.f, 0.f, 0.f, 0.f};
            if (row < 8) cv[i] = *(const f32x4*)(P.c_p + (size_t)row * 1024 + k); else if (row < 136) cv[i] = *(const f32x4*)(P.c_s + (size_t)(row - 8) * 1024 + k); } };
    for (int u = ustart; u < NMOD / 64; u += ustride) {
        const int j0 = u * 64; f32x4 acc[5], r[4], rn[4], cv[9], cn[9];
#pragma unroll
        for (int i = 0; i < 5; ++i) acc[i] = (f32x4){0.f, 0.f, 0.f, 0.f};
#pragma unroll
        for (int i = 0; i < 4; ++i) { const int idx = tid + NTHR * i, kr = idx >> 4, c4 = (idx & 15) * 4; r[i] = *(const f32x4*)(P.w_ada + (size_t)kr * NMOD + j0 + c4); }
        ldc(0, cv);
        for (int ch = 0; ch < 8; ++ch) {
            if (ch + 1 < 8) {
#pragma unroll
                for (int i = 0; i < 4; ++i) { const int idx = tid + NTHR * i, kr = idx >> 4, c4 = (idx & 15) * 4; rn[i] = *(const f32x4*)(P.w_ada + (size_t)((ch + 1) * 128 + kr) * NMOD + j0 + c4); }
                ldc(ch + 1, cn);
            }
            __syncthreads();
            LAS float* buf = sm + (ch & 1) * BUF;
#pragma unroll
            for (int i = 0; i < 4; ++i) { const int idx = tid + NTHR * i, kr = idx >> 4, c4 = (idx & 15) * 4; LAS float* q = buf + kr * PITCH + c4; q[0] = r[i][0]; q[1] = r[i][1]; q[2] = r[i][2]; q[3] = r[i][3]; }
#pragma unroll
            for (int i = 0; i < 9; ++i) { const int e = tid + NTHR * i, row = e >> 5, k4 = (e & 31) * 4; const f32x4 c = cv[i]; u32x2 w;
                w.x = cvt_pk_bf16(c[0] * sigmoidf_(c[0]), c[1] * sigmoidf_(c[1])); w.y = cvt_pk_bf16(c[2] * sigmoidf_(c[2]), c[3] * sigmoidf_(c[3]));
                *(LAS u32x2*)(sA + row * APITCH + k4) = w; }
            __syncthreads();
#pragma unroll
            for (int s_ = 0; s_ < 4; ++s_) { float w[8]; bf16x8 a[5];
#pragma unroll
                for (int i = 0; i < 5; ++i) { const int rb = (rb0 + 2 * i < 9) ? rb0 + 2 * i : rb0; a[i] = *(const LAS bf16x8*)(sA + (rb * 16 + fr) * APITCH + s_ * 32 + fq * 8); }
#pragma unroll
                for (int e = 0; e < 8; ++e) w[e] = buf[(s_ * 32 + fq * 8 + e) * PITCH + ct * 16 + fr];
                u32x4 pk; pk.x = cvt_pk_bf16(w[0], w[1]); pk.y = cvt_pk_bf16(w[2], w[3]); pk.z = cvt_pk_bf16(w[4], w[5]); pk.w = cvt_pk_bf16(w[6], w[7]);
                const bf16x8 bfr = __builtin_bit_cast(bf16x8, pk);
#pragma unroll
                for (int i = 0; i < 5; ++i) acc[i] = __builtin_amdgcn_mfma_f32_16x16x32_bf16(bfr, a[i], acc[i], 0, 0, 0); }
#pragma unroll
            for (int i = 0; i < 4; ++i) r[i] = rn[i];
#pragma unroll
            for (int i = 0; i < 9; ++i) cv[i] = cn[i];
        }
        const int col = j0 + ct * 16 + fq * 4; const f32x4 bias = *(const f32x4*)(P.b_ada + col);
#pragma unroll
        for (int i = 0; i < 5; ++i) { const int rb = rb0 + 2 * i, row = rb * 16 + fr; if (rb < 9 && row < 136) *(f32x4*)(mods + (size_t)row * NMOD + col) = acc[i] + bias; }
    }
    __syncthreads();
}
__device__ __forceinline__ void p0_s5_tables(KP& P, LAS float* sm) {
    LAS float* apr = sm; LAS float* api = apr + 17 * 64; LAS float* Br = api + 17 * 64; LAS float* Bi = Br + 1024; LAS float* Cr = Bi + 1024; LAS float* Ci = Cr + 1024; LAS float* Kt = Ci + 1024;
    const int tid = ltid(), G = gridDim.x;
    bf16_t* T1 = (bf16_t*)(P.ws + WS_BIG + BIG_TAB1); bf16_t* T2 = (bf16_t*)(P.ws + WS_BIG + BIG_TAB2);
    for (int g = (int)blockIdx.x; g < 64; g += G) {
        __syncthreads();
        for (int t = tid; t < 17 * 64; t += NTHR) { const int p = t & 63, e = t >> 6; double ar, ai; apow_d(P, g, p, (double)e, ar, ai); apr[e * 64 + p] = (float)ar; api[e * 64 + p] = (float)ai; }
        for (int t = tid; t < 1024; t += NTHR) { const int p = t >> 4, c = t & 15; double cr, ci; bcoef_d(P, g, p, cr, ci);
            const double br = (double)P.b_re[(g * 64 + p) * 16 + c], bi = (double)P.b_im[(g * 64 + p) * 16 + c];
            const float fr_ = (float)(cr * br - ci * bi), fi_ = (float)(cr * bi + ci * br);
            Br[p * 16 + c] = fr_; Bi[p * 16 + c] = fi_;
            float* bb = (float*)(P.ws + WS_BBAR) + ((size_t)(g * 64 + p) * 16 + c) * 2; bb[0] = fr_; bb[1] = fi_; }
        if (tid < 64) { float* sc = (float*)(P.ws + WS_S5C) + (size_t)(g * 64 + tid) * 8; double ar, ai;
            apow_d(P, g, tid, 1.0, ar, ai); sc[0] = (float)ar; sc[1] = (float)ai;
            apow_d(P, g, tid, 16.0, ar, ai); sc[2] = (float)ar; sc[3] = (float)ai;
            apow_d(P, g, tid, 512.0, ar, ai); sc[4] = (float)ar; sc[5] = (float)ai; sc[6] = 0.f; sc[7] = 0.f; }
        for (int t = tid; t < 1024; t += NTHR) { Cr[t] = P.c_re[g * 1024 + t]; Ci[t] = P.c_im[g * 1024 + t]; }
        __syncthreads();
        for (int idx = tid; idx < 4096; idx += NTHR) { const int e = idx >> 8, c = (idx >> 4) & 15, cp = idx & 15; float s = 0.f;
            for (int p = 0; p < 64; ++p) { const float ar = apr[e * 64 + p], ai = api[e * 64 + p], br = Br[p * 16 + cp], bi = Bi[p * 16 + cp];
                const float xr = ar * br - ai * bi, xi = ar * bi + ai * br; s += Cr[c * 64 + p] * xr - Ci[c * 64 + p] * xi; }
            Kt[idx] = s; }
        __syncthreads();
        for (int it = tid; it < 256 * 48; it += NTHR) { const int row = it / 48, kg = it % 48, l = row >> 4, c = row & 15; float v[8];
            if (kg < 32) { const int j = kg >> 1, c0 = (kg & 1) * 8;
#pragma unroll
                for (int i = 0; i < 8; ++i) v[i] = (j <= l) ? Kt[(l - j) * 256 + c * 16 + c0 + i] : 0.f;
            } else { const int q0 = (kg - 32) * 8;
#pragma unroll
                for (int i = 0; i < 8; ++i) { const int q = q0 + i, p = q & 63; const float cr = Cr[c * 64 + p], ci = Ci[c * 64 + p], ar = apr[(l + 1) * 64 + p], ai = api[(l + 1) * 64 + p];
                    v[i] = (q < 64) ? (cr * ar - ci * ai) : -(cr * ai + ci * ar); } }
            u32x4 w; w.x = cvt_pk_bf16(v[0], v[1]); w.y = cvt_pk_bf16(v[2], v[3]); w.z = cvt_pk_bf16(v[4], v[5]); w.w = cvt_pk_bf16(v[6], v[7]);
            *(u32x4*)(T2 + ((size_t)g * 256 + row) * 384 + kg * 8) = w; }
        for (int it = tid; it < 128 * 32; it += NTHR) { const int q = it >> 5, kg = it & 31, j = kg >> 1, c0 = (kg & 1) * 8, p = q & 63; float v[8];
            const float ar = apr[(15 - j) * 64 + p], ai = api[(15 - j) * 64 + p];
#pragma unroll
            for (int i = 0; i < 8; ++i) { const float br = Br[p * 16 + c0 + i], bi = Bi[p * 16 + c0 + i]; v[i] = (q < 64) ? (ar * br - ai * bi) : (ar * bi + ai * br); }
            u32x4 w; w.x = cvt_pk_bf16(v[0], v[1]); w.y = cvt_pk_bf16(v[2], v[3]); w.z = cvt_pk_bf16(v[4], v[5]); w.w = cvt_pk_bf16(v[6], v[7]);
            *(u32x4*)(T1 + ((size_t)g * 128 + q) * 256 + kg * 8) = w; }
    }
}

__device__ __forceinline__ void modulate_phase(KP& P) { const int tidl_ = ltid();
    const int wid = tidl_ >> 6, lane = tidl_ & 63; const float* mods = (const float*)(P.ws + WS_MODS); bf16_t* hA = (bf16_t*)(P.ws + WS_H);
    const int G_ = gridDim.x, nw = G_ * 8, per = nw >> 3;
    if ((G_ & 7) == 0) {
        const int vb = ((int)blockIdx.x % 8) * (G_ / 8) + (int)blockIdx.x / 8, w = vb * 8 + wid, bseq = w / per, r0 = w - bseq * per;
        const float* sh = mods + (size_t)bseq * NMOD; const float* sc = sh + 1024;
#pragma unroll 2
        for (int l = r0; l < SEQ; l += per) { const size_t row = (size_t)bseq * SEQ + l;
#pragma unroll
            for (int i = 0; i < 4; ++i) { const int c = i * 256 + lane * 4; const f32x4 x = *(const f32x4*)(P.x_p + row * 1024 + c), a = *(const f32x4*)(sc + c), b = *(const f32x4*)(sh + c);
                u32x2 wv; wv.x = cvt_pk_bf16(x[0] * (1.f + a[0]) + b[0], x[1] * (1.f + a[1]) + b[1]); wv.y = cvt_pk_bf16(x[2] * (1.f + a[2]) + b[2], x[3] * (1.f + a[3]) + b[3]);
                *(u32x2*)(hA + row * 1024 + c) = wv; } }
    }
    for (int row = ((G_ & 7) == 0 ? MP : 0) + blockIdx.x * 8 + wid; row < MT; row += G_ * 8) {
        const int ns = row < MP ? (row >> 11) : 8 + (row - MP); const float* xr = row < MP ? P.x_p + (size_t)row * 1024 : P.x_s + (size_t)(row - MP) * 1024;
        const float* sh = mods + (size_t)ns * NMOD; const float* sc = sh + 1024;
#pragma unroll
        for (int i = 0; i < 4; ++i) { const int c = i * 256 + lane * 4; const f32x4 x = *(const f32x4*)(xr + c), a = *(const f32x4*)(sc + c), b = *(const f32x4*)(sh + c);
            u32x2 w; w.x = cvt_pk_bf16(x[0] * (1.f + a[0]) + b[0], x[1] * (1.f + a[1]) + b[1]); w.y = cvt_pk_bf16(x[2] * (1.f + a[2]) + b[2], x[3] * (1.f + a[3]) + b[3]);
            *(u32x2*)(hA + (size_t)row * 1024 + c) = w; }
    }
}
__device__ __forceinline__ void ln_finish(int row, f32x4 (&v)[4], int lane, const f32x4 (&gg)[4], const f32x4 (&bb)[4], const f32x4 (&sh)[4], const f32x4 (&sc)[4], float* xout, bool has_next, bf16_t* hA, float* stats) {
    float s = 0.f;
#pragma unroll
    for (int i = 0; i < 4; ++i) s += (v[i][0] + v[i][1]) + (v[i][2] + v[i][3]);
    const float mean = wave_sum(s) * (1.0f / 1024.0f); float q = 0.f;
#pragma unroll
    for (int i = 0; i < 4; ++i) { const f32x4 d = v[i] - mean; q += (d[0] * d[0] + d[1] * d[1]) + (d[2] * d[2] + d[3] * d[3]); }
    const float rstd = 1.0f / sqrtf(wave_sum(q) * (1.0f / 1024.0f) + LN_EPS);
    if (stats && lane == 0) { stats[(size_t)row * 2] = mean; stats[(size_t)row * 2 + 1] = rstd; }
#pragma unroll
    for (int i = 0; i < 4; ++i) { const int c = i * 256 + lane * 4;
        const f32x4 xn = (v[i] - mean) * rstd * gg[i] + bb[i];
        if (!stats) *(f32x4*)(xout + (size_t)row * 1024 + c) = xn;
        if (has_next) { u32x2 w; w.x = cvt_pk_bf16(xn[0] * (1.f + sc[i][0]) + sh[i][0], xn[1] * (1.f + sc[i][1]) + sh[i][1]); w.y = cvt_pk_bf16(xn[2] * (1.f + sc[i][2]) + sh[i][2], xn[3] * (1.f + sc[i][3]) + sh[i][3]);
            *(u32x2*)(hA + (size_t)row * 1024 + c) = w; } }
}
__device__ __forceinline__ void ln_phase(KP& P, int li, int lj, int smode, int KS, const float* xres_s, int next_off  , bool do_prompt) { const int tidl_ = ltid();
    const int wid = tidl_ >> 6, lane = tidl_ & 63; const float* mods = (const float*)(P.ws + WS_MODS); bf16_t* hA = (bf16_t*)(P.ws + WS_H);
    const bf16_t* T = (const bf16_t*)(P.ws + WS_T); const float* raw = (const float*)(P.ws + WS_RAW);
    const float* lg = P.ln_g + (li * 2 + lj) * 1024; const float* lb = P.ln_b + (li * 2 + lj) * 1024; const int gate_off = ((li * 2 + lj) * 3 + 2) * 1024;
    const int stride = gridDim.x * 8; const bool has_next = next_off >= 0;
    f32x4 gg[4], bb[4], sh[4], sc[4];
#pragma unroll
    for (int i = 0; i < 4; ++i) { const int c = i * 256 + lane * 4; gg[i] = *(const f32x4*)(lg + c); bb[i] = *(const f32x4*)(lb + c); sh[i] = (f32x4){0.f, 0.f, 0.f, 0.f}; sc[i] = sh[i]; }
    if (do_prompt) {
        const int G_ = gridDim.x, vb = (G_ % 8 == 0) ? ((int)blockIdx.x % 8) * (G_ / 8) + (int)blockIdx.x / 8 : (int)blockIdx.x;
        const int nw = stride, w = vb * 8 + wid, per = nw >> 3;
        if ((nw & 7) == 0 && per > 0) {
            const int bseq = w / per, r0 = w - bseq * per;
            if (has_next) {
#pragma unroll
                for (int i = 0; i < 4; ++i) { const int c = i * 256 + lane * 4; sh[i] = *(const f32x4*)(mods + (size_t)bseq * NMOD + next_off + c); sc[i] = *(const f32x4*)(mods + (size_t)bseq * NMOD + next_off + 1024 + c); }
            }
            int l = r0; f32x4 v[4], nx[4];
            if (l < SEQ) {
#pragma unroll
                for (int i = 0; i < 4; ++i) { const u32x2 w = *(const u32x2*)(T + (size_t)(bseq * SEQ + l) * 1024 + i * 256 + lane * 4); v[i] = (f32x4){bflo(w.x), bfhi(w.x), bflo(w.y), bfhi(w.y)}; }
            }
            for (; l < SEQ; l += per) { const int nl = l + per;
                if (nl < SEQ) {
#pragma unroll
                    for (int i = 0; i < 4; ++i) { const u32x2 w = *(const u32x2*)(T + (size_t)(bseq * SEQ + nl) * 1024 + i * 256 + lane * 4); nx[i] = (f32x4){bflo(w.x), bfhi(w.x), bflo(w.y), bfhi(w.y)}; }
                }
                ln_finish(bseq * SEQ + l, v, lane, gg, bb, sh, sc, P.out + O_Y, has_next, hA, (float*)(P.ws + WS_STATS));
#pragma unroll
                for (int i = 0; i < 4; ++i) v[i] = nx[i];
            }
        }
    }
    for (int n = (gridDim.x - 1 - blockIdx.x) * 8 + wid; n < NS; n += stride) {
        const int row = MP + n, ns = 8 + n; f32x4 v[4];
#pragma unroll
        for (int i = 0; i < 4; ++i) { const int c = i * 256 + lane * 4; f32x4 o;
            if (smode == 0) { const f32x4 a = rawsum4(raw, (size_t)n * 2048 + pcol(c), KS, (size_t)128 * 2048), gt = rawsum4(raw, (size_t)n * 2048 + pcol(c) + 128, KS, (size_t)128 * 2048);
#pragma unroll
                for (int j = 0; j < 4; ++j) o[j] = a[j] * sigmoidf_(gt[j]);
            } else o = rawsum4(raw, (size_t)n * 1024 + c, KS, (size_t)128 * 1024);
            const f32x4 xr = *(const f32x4*)(xres_s + (size_t)n * 1024 + c), gm = *(const f32x4*)(mods + (size_t)ns * NMOD + gate_off + c);
            v[i] = ALPHA * xr + gm * o;
            if (has_next) { sh[i] = *(const f32x4*)(mods + (size_t)ns * NMOD + next_off + c); sc[i] = *(const f32x4*)(mods + (size_t)ns * NMOD + next_off + 1024 + c); } }
        ln_finish(row, v, lane, gg, bb, sh, sc, P.out + O_Y, has_next, hA, nullptr);
    }
}

__device__ __forceinline__ void s5_prompt(KP& P, LAS unsigned char* lds) {
    bf16_t* A2 = (bf16_t*)(P.ws + WS_T); bf16_t* hA = (bf16_t*)(P.ws + WS_H);
    for (int idx = blockIdx.x; idx < 256; idx += gridDim.x) {
        const int g = idx >> 2, pm = idx & 3;
        bf16_t* A2g = A2 + (size_t)g * 1024 * 384;
        float* Slg = (float*)(P.ws + WS_BIG + BIG_SLOC) + (size_t)g * 1024 * 128;
        { Gemm gm{A2g, (const bf16_t*)(P.ws + WS_BIG + BIG_TAB1) + (size_t)g * 128 * 256, 384, 256, 256}; OneUnit S{{pm, 0}}; EpiS1 E{Slg}; gemm_phase(lds, gm, S, E); }
        asm volatile("s_waitcnt vmcnt(0)" ::: "memory"); __syncthreads();
        {
            const int tid = ltid();
            const int nl = tid >> 8, seg = (tid >> 6) & 3, p = tid & 63; const int rowbase = pm * 256 + nl * 128 + seg * 32;
            const float* sl = Slg + (size_t)rowbase * 128; float lre[32], lim[32];
#pragma unroll
            for (int k = 0; k < 32; ++k) { lre[k] = sl[k * 128 + p]; lim[k] = sl[k * 128 + 64 + p]; }
            const float* sc = (const float*)(P.ws + WS_S5C) + (size_t)(g * 64 + p) * 8;
            const float a16r = sc[2], a16i = sc[3], a512r = sc[4], a512i = sc[5];
            float sr = 0.f, si = 0.f;
#pragma unroll
            for (int k = 0; k < 32; ++k) { const float nr = a16r * sr - a16i * si + lre[k], ni = a16r * si + a16i * sr + lim[k]; sr = nr; si = ni; lre[k] = sr; lim[k] = si; }
            LAS float* Eb = (LAS float*)lds;
            Eb[((nl * 4 + seg) * 64 + p) * 2] = sr; Eb[((nl * 4 + seg) * 64 + p) * 2 + 1] = si;
            __syncthreads();
            float cr = 0.f, ci = 0.f;
            for (int s2 = 0; s2 < seg; ++s2) { const float er = Eb[((nl * 4 + s2) * 64 + p) * 2], ei = Eb[((nl * 4 + s2) * 64 + p) * 2 + 1];
                const float nr = a512r * cr - a512i * ci + er, ni = a512r * ci + a512i * cr + ei; cr = nr; ci = ni; }
            float pwr = 1.f, pwi = 0.f; bf16_t* dst = A2g + (size_t)rowbase * 384 + 256 + p;
#pragma unroll
            for (int k = 0; k < 32; ++k) { float vr, vi;
                if (k == 0) { vr = cr; vi = ci; } else { vr = lre[k - 1] + (pwr * cr - pwi * ci); vi = lim[k - 1] + (pwr * ci + pwi * cr); }
                const unsigned w = cvt_pk_bf16(vr, vi); dst[(size_t)k * 384] = (bf16_t)(w & 0xffffu); dst[(size_t)k * 384 + 64] = (bf16_t)(w >> 16);
                const float nr = pwr * a16r - pwi * a16i, ni = pwr * a16i + pwi * a16r; pwr = nr; pwi = ni; }
            if (seg == 3) { const int n = pm * 2 + nl;
                P.out[O_S5RE_P + (size_t)(n * 64 + g) * 64 + p] = lre[31] + (pwr * cr - pwi * ci);
                P.out[O_S5IM_P + (size_t)(n * 64 + g) * 64 + p] = lim[31] + (pwr * ci + pwi * cr); }
        }
        asm volatile("s_waitcnt vmcnt(0)" ::: "memory"); __syncthreads();
        { Gemm gm{A2g, (const bf16_t*)(P.ws + WS_BIG + BIG_TAB2) + (size_t)g * 256 * 384, 384, 384, 384}; OneUnit S{{pm, 0}}; EpiS2 E{A2g, P.s5_d, hA, g}; gemm_phase(lds, gm, S, E); }
        __syncthreads();
    }
}
__device__ __forceinline__ void s5_sample(KP& P) { const int tidl_ = ltid();
    const int wid = tidl_ >> 6, lane = tidl_ & 63; const float* raw = (const float*)(P.ws + WS_RAW); bf16_t* hA = (bf16_t*)(P.ws + WS_H);
    for (int wi = blockIdx.x * 8 + wid; wi < 2048; wi += gridDim.x * 8) {
        const int g = wi >> 5, n0 = (wi & 31) * 4, p = lane;
        const float* sc = (const float*)(P.ws + WS_S5C) + (size_t)(g * 64 + p) * 8; const float far = sc[0], fai = sc[1];
        const float* bbp = (const float*)(P.ws + WS_BBAR) + (size_t)(g * 64 + p) * 32;
        float Bre[16], Bim[16], Cre[16], Cim[16];
#pragma unroll
        for (int c = 0; c < 16; ++c) { Bre[c] = bbp[c * 2]; Bim[c] = bbp[c * 2 + 1];
            Cre[c] = P.c_re[(g * 16 + c) * 64 + p]; Cim[c] = P.c_im[(g * 16 + c) * 64 + p]; }
        const int cl = ((lane & 1) << 3) | ((lane & 2) << 1) | ((lane & 4) >> 1) | ((lane & 8) >> 3);
        const float dl = P.s5_d[g * 16 + cl];
        for (int nn = 0; nn < 4; ++nn) { const int n = n0 + nn;
            const float h0r = P.s5re[(size_t)(n * 64 + g) * 64 + p], h0i = P.s5im[(size_t)(n * 64 + g) * 64 + p];
            float sr = far * h0r - fai * h0i, si = far * h0i + fai * h0r;
#pragma unroll
            for (int c = 0; c < 16; ++c) { const float uc = raw[(size_t)n * 1024 + g * 16 + c]; sr += Bre[c] * uc; si += Bim[c] * uc; }
            P.out[O_S5RE_S + (size_t)(n * 64 + g) * 64 + p] = sr; P.out[O_S5IM_S + (size_t)(n * 64 + g) * 64 + p] = si;
            float v16[16];
#pragma unroll
            for (int c = 0; c < 16; ++c) v16[c] = Cre[c] * sr - Cim[c] * si;
            const bool b0 = lane & 1, b1 = lane & 2, b2 = lane & 4, b3 = lane & 8;
            float r8[8], s4[4], t2[2];
#pragma unroll
            for (int j = 0; j < 8; ++j) { const float mine = b0 ? v16[j + 8] : v16[j], send = b0 ? v16[j] : v16[j + 8]; r8[j] = mine + dppx<0xB1>(send); }
#pragma unroll
            for (int j = 0; j < 4; ++j) { const float mine = b1 ? r8[j + 4] : r8[j], send = b1 ? r8[j] : r8[j + 4]; s4[j] = mine + dppx<0x4E>(send); }
#pragma unroll
            for (int j = 0; j < 2; ++j) { const float mine = b2 ? s4[j + 2] : s4[j], send = b2 ? s4[j] : s4[j + 2]; t2[j] = mine + __shfl_xor(send, 4); }
            float ysel; { const float mine = b3 ? t2[1] : t2[0], send = b3 ? t2[0] : t2[1]; ysel = mine + dppx<0x128>(send); }
            ysel += __shfl_xor(ysel, 16); ysel += __shfl_xor(ysel, 32);
            if (lane < 16) { const float ul = raw[(size_t)n * 1024 + g * 16 + cl]; const float y = gelu_tanh(ysel + dl * ul);
                hA[(size_t)(MP + n) * 1024 + g * 16 + cl] = (bf16_t)(cvt_pk_bf16(y, 0.f) & 0xffffu); }
        }
    }
}

__device__ __forceinline__ void unpack8(const u32x4 w, float (&f)[8]) { f[0] = bflo(w.x); f[1] = bfhi(w.x); f[2] = bflo(w.y); f[3] = bfhi(w.y); f[4] = bflo(w.z); f[5] = bfhi(w.z); f[6] = bflo(w.w); f[7] = bfhi(w.w); }
__device__ __forceinline__ void ld8(const float* p, float (&f)[8]) { const f32x4 a = *(const f32x4*)p, b = *(const f32x4*)(p + 4); f[0] = a[0]; f[1] = a[1]; f[2] = a[2]; f[3] = a[3]; f[4] = b[0]; f[5] = b[1]; f[6] = b[2]; f[7] = b[3]; }
__device__ __forceinline__ void st8(float* p, const float (&f)[8]) { *(f32x4*)p = (f32x4){f[0], f[1], f[2], f[3]}; *(f32x4*)(p + 4) = (f32x4){f[4], f[5], f[6], f[7]}; }
__device__ __forceinline__ void ffn_fixup_rows(KP& P, int layer, int pm) { const int tidl_ = ltid();
    const bf16_t* halo = (const bf16_t*)(P.ws + WS_BIG + BIG_HALO); bf16_t* act = (bf16_t*)(P.ws + WS_BIG);
    const float* cw = P.ffn_conv_w + (size_t)layer * 3 * DFF2; const float* cb = P.ffn_conv_b + (size_t)layer * DFF2;
    constexpr int NOCT = DFF / 8;
    for (int id = tidl_; id < 4 * NOCT; id += NTHR) {
        float x0[2][8], x1[2][8], x2[2][8], w0[2][8], w1[2][8], w2[2][8], bb[2][8];
        const int loc = id / NOCT, oct = id - loc * NOCT, c0 = oct * 8;
        const int blk = pm * 2 + (loc >> 1), rr = loc & 1; const bool hp = (blk & 15) != 0; const size_t orow = (size_t)(blk * 128 + rr);
        const bf16_t* h0 = halo + (size_t)(blk * 4 + rr) * DFF2;
        const bf16_t* h1 = rr ? halo + (size_t)(blk * 4) * DFF2 : halo + (size_t)((blk - 1) * 4 + 3) * DFF2; const bool v1 = rr ? true : hp;
        const bf16_t* h2 = rr ? halo + (size_t)((blk - 1) * 4 + 3) * DFF2 : halo + (size_t)((blk - 1) * 4 + 2) * DFF2; const bool v2 = hp;
#pragma unroll
        for (int part = 0; part < 2; ++part) { const int col = part * DFF + c0;
            unpack8(*(const u32x4*)(h0 + col), x0[part]);
            if (v1) unpack8(*(const u32x4*)(h1 + col), x1[part]); else { for (int j = 0; j < 8; ++j) x1[part][j] = 0.f; }
            if (v2) unpack8(*(const u32x4*)(h2 + col), x2[part]); else { for (int j = 0; j < 8; ++j) x2[part][j] = 0.f; }
            ld8(cw + col, w0[part]); ld8(cw + DFF2 + col, w1[part]); ld8(cw + 2 * DFF2 + col, w2[part]); ld8(cb + col, bb[part]); }
        float o[8];
#pragma unroll
        for (int j = 0; j < 8; ++j) { const float cv = w2[0][j] * x0[0][j] + w1[0][j] * x1[0][j] + w0[0][j] * x2[0][j] + bb[0][j], cg_ = w2[1][j] * x0[1][j] + w1[1][j] * x1[1][j] + w0[1][j] * x2[1][j] + bb[1][j];
            o[j] = gelu_tanh(cg_) * cv; }
        u32x4 w; w.x = cvt_pk_bf16(o[0], o[1]); w.y = cvt_pk_bf16(o[2], o[3]); w.z = cvt_pk_bf16(o[4], o[5]); w.w = cvt_pk_bf16(o[6], o[7]);
        *(u32x4*)(act + orow * DFF + c0) = w;
    }
    asm volatile("s_waitcnt vmcnt(0)" ::: "memory"); __syncthreads();
}

__device__ __forceinline__ void shortconv_phase(KP& P) { const int tidl_ = ltid();
    const int G = gridDim.x; const bf16_t* z2 = (const bf16_t*)(P.ws + WS_BIG); bf16_t* hA = (bf16_t*)(P.ws + WS_H); const float* raw = (const float*)(P.ws + WS_RAW);
    const int c0 = (tidl_ & 127) * 8; float w0[8], w1[8], w2[8];
    ld8(P.sc_conv_w + c0, w0); ld8(P.sc_conv_w + 1024 + c0, w1); ld8(P.sc_conv_w + 2048 + c0, w2);
    const int vb_ = (G % 8 == 0) ? ((int)blockIdx.x % 8) * (G / 8) + (int)blockIdx.x / 8 : (int)blockIdx.x;
    const bool al_ = (G == 256); const int nk_ = al_ ? 16 : (MP + G * 4 - 1) / (G * 4);
#pragma unroll 4
    for (int k_ = 0; k_ < nk_; ++k_) { const int r = al_ ? (vb_ >> 5) * SEQ + (vb_ & 31) * 4 + (tidl_ >> 7) + 128 * k_ : (int)blockIdx.x * 4 + (tidl_ >> 7) + k_ * G * 4; if (r >= MP) break;
        const int l = r & 2047; float cur[8], m1[8], m2[8], gb[8], q[8];
        unpack8(*(const u32x4*)(z2 + (size_t)r * 2048 + 1024 + c0), cur); unpack8(*(const u32x4*)(z2 + (size_t)r * 2048 + c0), gb);
        if (l >= 1) unpack8(*(const u32x4*)(z2 + (size_t)(r - 1) * 2048 + 1024 + c0), m1); else { for (int j = 0; j < 8; ++j) m1[j] = 0.f; }
        if (l >= 2) unpack8(*(const u32x4*)(z2 + (size_t)(r - 2) * 2048 + 1024 + c0), m2); else { for (int j = 0; j < 8; ++j) m2[j] = 0.f; }
#pragma unroll
        for (int j = 0; j < 8; ++j) q[j] = gb[j] * (w0[j] * m2[j] + w1[j] * m1[j] + w2[j] * cur[j]);
        u32x4 w; w.x = cvt_pk_bf16(q[0], q[1]); w.y = cvt_pk_bf16(q[2], q[3]); w.z = cvt_pk_bf16(q[4], q[5]); w.w = cvt_pk_bf16(q[6], q[7]);
        *(u32x4*)(hA + (size_t)r * 1024 + c0) = w;
        if (l >= 2046) st8(P.out + O_CONV_P + (size_t)((r >> 11) * 2 + (l - 2046)) * 1024 + c0, cur);
    }
    for (int id = (G - 1 - (int)blockIdx.x) * NTHR + tidl_; id < NS * 128; id += G * NTHR) {
        const int n = id >> 7; float gb[8], gc[8], v[8], b0[8], b1[8], cvs[8], q[8];
        ld8(raw + (size_t)n * 3072 + c0, gb); ld8(raw + (size_t)n * 3072 + 1024 + pcol(c0), gc); ld8(raw + (size_t)n * 3072 + 1024 + pcol(c0) + 128, v);
        ld8(P.st_conv + (size_t)(n * 2) * 1024 + c0, b0); ld8(P.st_conv + (size_t)(n * 2 + 1) * 1024 + c0, b1);
#pragma unroll
        for (int j = 0; j < 8; ++j) { cvs[j] = gc[j] * v[j]; q[j] = gb[j] * (w0[j] * b0[j] + w1[j] * b1[j] + w2[j] * cvs[j]); }
        st8(P.out + O_CONV_S + (size_t)(n * 2) * 1024 + c0, b1); st8(P.out + O_CONV_S + (size_t)(n * 2 + 1) * 1024 + c0, cvs);
        u32x4 w; w.x = cvt_pk_bf16(q[0], q[1]); w.y = cvt_pk_bf16(q[2], q[3]); w.z = cvt_pk_bf16(q[4], q[5]); w.w = cvt_pk_bf16(q[6], q[7]);
        *(u32x4*)(hA + (size_t)(MP + n) * 1024 + c0) = w;
    }
}

#define XB_TMO      128
#define XB_XCNT(j)  (256  + 64 * (j))
#define XB_XSUB(j)  (1280 + 64 * (j))
#define XB_XGEN(j)  (2304 + 64 * (j))
#define XB_TOP      3328
#define XB_TOPGEN   3392
#define XCD_BAR_WORDS 3456
#define XB_SPIN_CAP (1u << 20)
__device__ __forceinline__ unsigned xb_ld(unsigned* p)              { return __hip_atomic_load(p, __ATOMIC_RELAXED, __HIP_MEMORY_SCOPE_AGENT); }
__device__ __forceinline__ unsigned xb_add(unsigned* p, unsigned v) { return __hip_atomic_fetch_add(p, v, __ATOMIC_RELAXED, __HIP_MEMORY_SCOPE_AGENT); }
__device__ __forceinline__ unsigned xb_xcc_id() { return (unsigned)__builtin_amdgcn_s_getreg((3 << 11) | 20) & 0xFu; }
#define XB_SPIN(cond, bar) do { unsigned _sp = 0; while (cond) { \
    if ((++_sp & 255u) == 0u) { if (xb_ld(&(bar)[XB_TMO])) break; if (_sp > XB_SPIN_CAP) { atomicAdd(&(bar)[XB_TMO], 1u); break; } } } } while (0)
__device__ __forceinline__ void xcd_barrier_complete(unsigned* bar, unsigned x, unsigned& nloc, unsigned& nx) {
    const unsigned G = gridDim.x; unsigned sum, cnt, mine, sp = 0u;
    for (;;) {
        sum = 0u; cnt = 0u; mine = 0u;
#pragma unroll
        for (unsigned j = 0; j < 16; ++j) { const unsigned c = xb_ld(&bar[XB_XCNT(j)]); sum += c; cnt += (c > 0u) ? 1u : 0u; mine = (j == x) ? c : mine; }
        if (sum == G) break;
        __builtin_amdgcn_s_sleep(1);
        if ((++sp & 255u) == 0u) { if (xb_ld(&bar[XB_TMO])) break; if (sp > XB_SPIN_CAP) { atomicAdd(&bar[XB_TMO], 1u); break; } }
    }
    nloc = mine > 0u ? mine : 1u; nx = cnt > 0u ? cnt : 1u;
}
__device__ __forceinline__ void grid_bar(unsigned* bar, volatile LAS unsigned* st) {
    asm volatile("s_waitcnt vmcnt(0)" ::: "memory");
    __syncthreads();
    if (ltid() == 0) {
        const unsigned x = xb_xcc_id();
        __builtin_amdgcn_s_waitcnt(0);
        unsigned nloc = st[0], nx = st[1];
        if (nloc == 0u) { xcd_barrier_complete(bar, x, nloc, nx); st[0] = nloc; st[1] = nx; }
        const unsigned old = xb_add(&bar[XB_XSUB(x)], 1u);
        const unsigned gen = old / nloc;
        if (old + 1u == (gen + 1u) * nloc) {
            __builtin_amdgcn_fence(__ATOMIC_RELEASE, "agent");
            asm volatile("s_waitcnt vmcnt(0)" ::: "memory");
            const unsigned og = xb_add(&bar[XB_TOP], 1u);
            const unsigned tg = og / nx;
            if (og + 1u == (tg + 1u) * nx) xb_add(&bar[XB_TOPGEN], 1u);
            else XB_SPIN(xb_ld(&bar[XB_TOPGEN]) == tg, bar);
            __builtin_amdgcn_fence(__ATOMIC_ACQUIRE, "agent");
            xb_add(&bar[XB_XGEN(x)], 1u);
            asm volatile("s_waitcnt vmcnt(0)" ::: "memory");
        } else {
            XB_SPIN(xb_ld(&bar[XB_XGEN(x)]) == gen, bar);
            __builtin_amdgcn_fence(__ATOMIC_ACQUIRE, "agent");
            asm volatile("s_waitcnt vmcnt(0)" ::: "memory");
        }
    }
    __syncthreads();
}

__device__ __forceinline__ void sample_gate(KP& P, int slot) {
    const int r = (int)gridDim.x - 1 - (int)blockIdx.x; unsigned* c = (unsigned*)(P.ws + WS_CNT) + 3072 + 96 + slot * 16;
    asm volatile("s_waitcnt vmcnt(0)" ::: "memory"); __syncthreads();
    if (ltid() == 0) {
        if (r < 64) { __builtin_amdgcn_fence(__ATOMIC_RELEASE, "agent"); asm volatile("s_waitcnt vmcnt(0)" ::: "memory"); __hip_atomic_fetch_add(c, 1u, __ATOMIC_RELAXED, __HIP_MEMORY_SCOPE_AGENT); }
        if (r < 16) { unsigned spins = 0; while (__hip_atomic_load(c, __ATOMIC_RELAXED, __HIP_MEMORY_SCOPE_AGENT) < 64u) { __builtin_amdgcn_s_sleep(2); if (++spins > (1u << 22)) break; }
            __builtin_amdgcn_fence(__ATOMIC_ACQUIRE, "agent"); asm volatile("s_waitcnt vmcnt(0)" ::: "memory"); }
    }
    __syncthreads();
}

__global__ void __launch_bounds__(NTHR) fwd_kernel(Params P_unused) {
    LAS unsigned char* lds = (LAS unsigned char*)lds_raw;
    { const unsigned slot = (unsigned)__builtin_amdgcn_s_getreg((5 << 11) | 4) & 63u; if ((threadIdx.x & 63) == 0) ((volatile LAS int*)(lds + LDS_WTAB))[slot] = (int)(threadIdx.x >> 6); __syncthreads(); }
    const int G = gridDim.x, bx = blockIdx.x;
    const int lo = getP().ph_lo, hi = getP().ph_hi;
    if (lo < 0) cg::this_grid().sync();
#define BST ((volatile LAS unsigned*)((LAS unsigned char*)lds_raw + 131072 + 64))
    if (ltid() == 0) { BST[0] = 0u; BST[1] = 0u; if (hi - lo > 1) (void)xb_add(&((unsigned*)(getP().ws + WS_BAR))[XB_XCNT(xb_xcc_id())], 1u); }
    __syncthreads();
#define GBAR() do { grid_bar((unsigned*)(getP().ws + WS_BAR), BST); } while (0)
#define PHASE_VARS KP& P = getP(); unsigned char* ws = P.ws; const float* mods = (const float*)(ws + WS_MODS); bf16_t* hA = (bf16_t*)(ws + WS_H); float* T = (float*)(ws + WS_T); float* raw = (float*)(ws + WS_RAW); bf16_t* act = (bf16_t*)(ws + WS_BIG); \
    (void)mods; (void)hA; (void)T; (void)raw; (void)act;
#ifndef ONLYP
#define ONLYP (-1)
#endif
#define IN(k) ((ONLYP < 0 || (k) == ONLYP) && lo <= (k) && (k) < hi)
#define SEAM(k) do { if (IN(k) && IN((k) + 1)) { GBAR(); for (int xs_ = 0; xs_ < XSYNC; ++xs_) GBAR(); } } while (0)
#define MOD_OFF(i, j, k) ((((i) * 2 + (j)) * 3 + (k)) * 1024)

    if (IN(0)) for (int rep_ = 0; rep_ < 1 + (int)((REPMASK >> (0)) & 1u); ++rep_) { if (rep_) GBAR(); PHASE_VARS
        p0_s5_tables(P, (LAS float*)lds); __syncthreads();
        mods_phase(P, (LAS float*)lds, (G == 256) ? (bx >= 64 ? bx - 64 : (1 << 30)) : bx, (G == 256) ? 192 : G);
        p0_convert(P, (LAS float*)lds); } SEAM(0);
    if (IN(2)) for (int rep_ = 0; rep_ < 1 + (int)((REPMASK >> (2)) & 1u); ++rep_) { if (rep_) GBAR(); PHASE_VARS modulate_phase(P); } SEAM(2);
    if (IN(3)) for (int rep_ = 0; rep_ < 1 + (int)((REPMASK >> (3)) & 1u); ++rep_) { if (rep_) GBAR(); PHASE_VARS
        { Gemm g{hA, (const bf16_t*)(ws + WS_WIN), 1024, 1024, 1024}; StaticOrder S; S.init(MP, 1024, G, bx); EpiWin E{(bf16_t*)(ws + WS_T)}; gemm_phase(lds, g, S, E); }
        skinny3((LAS float*)lds, hA + (size_t)MP * 1024, 1024, (const bf16_t*)(ws + WS_WIN), 1024, raw, G - 1 - bx, G);
    } SEAM(3);
    if (IN(4)) for (int rep_ = 0; rep_ < 1 + (int)((REPMASK >> (4)) & 1u); ++rep_) { if (rep_) GBAR(); PHASE_VARS for (int q_ = 0; q_ < S5P_REP; ++q_) s5_prompt(P, lds); for (int q_ = 0; q_ < S5S_REP; ++q_) s5_sample(P); } SEAM(4);
    if (IN(5)) for (int rep_ = 0; rep_ < 1 + (int)((REPMASK >> (5)) & 1u); ++rep_) { if (rep_) GBAR(); PHASE_VARS
        { Gemm g{hA, (const bf16_t*)(ws + WS_WGLU), 1024, 1024, 1024}; StaticOrder S; S.init(MP, 2048, G, bx); EpiGlu E{P.x_p, mods + MOD_OFF(0, 0, 2), (bf16_t*)T}; gemm_phase(lds, g, S, E); }
        skinny3((LAS float*)lds, hA + (size_t)MP * 1024, 1024, (const bf16_t*)(ws + WS_WGLU), 2048, raw, G - 1 - bx, G);
    } SEAM(5);
    if (IN(6)) for (int rep_ = 0; rep_ < 1 + (int)((REPMASK >> (6)) & 1u); ++rep_) { if (rep_) GBAR(); PHASE_VARS ln_phase(P, 0, 0, 0, 1, P.x_s, MOD_OFF(0, 1, 0), true); } SEAM(6);
#pragma unroll 1
    for (int layer = 0; layer < 2; ++layer) {
        const int pb = layer ? 15 : 7;
        if (IN(pb)) for (int rep_ = 0; rep_ < 1 + (int)((REPMASK >> (pb)) & 1u); ++rep_) { if (rep_) GBAR(); PHASE_VARS
            { Gemm g{hA, (const bf16_t*)(ws + WS_UP) + (size_t)layer * DFF2 * 1024, 1024, 1024, 1024}; StaticOrder S; S.init(MP, DFF2, G, bx);
              EpiUp E{act, (bf16_t*)(ws + WS_BIG + BIG_HALO), P.out + O_FFN_P + (size_t)layer * NB * 2 * DFF2, P.ffn_conv_w + (size_t)layer * 3 * DFF2, P.ffn_conv_b + (size_t)layer * DFF2};
              gemm_phase(lds, g, S, E); }
            skinny_up(P, layer, (LAS float*)lds, hA + (size_t)MP * 1024, (const bf16_t*)(ws + WS_UP) + (size_t)layer * DFF2 * 1024, (G == 256) ? (bx >= 128 ? bx - 128 : (1 << 30)) : G - 1 - bx, (G == 256) ? 128 : G);
        } SEAM(pb);
        if (IN(pb + 2)) for (int rep_ = 0; rep_ < 1 + (int)((REPMASK >> (pb + 2)) & 1u); ++rep_) { if (rep_) GBAR(); PHASE_VARS
            { Gemm g{act, (const bf16_t*)(ws + WS_DOWN) + (size_t)layer * 1024 * DFF, DFF, DFF, DFF}; StaticOrder S; S.init(MP, 1024, G, bx);
              { Unit u0; if (S.next(0, u0)) ffn_fixup_rows(P, layer, u0.pm); }
              if (layer == 0) { EpiLnT<1, false> E{nullptr, (bf16_t*)(ws + WS_T + (size_t)32 * 1024 * 1024), (const bf16_t*)T, (const float*)(ws + WS_STATS), P.ln_g, P.ln_b, nullptr, mods, MOD_OFF(0, 1, 2), MOD_OFF(1, 0, 0), P.ln_g + 1024, P.ln_b + 1024, P.out + O_Y, hA, (unsigned long long*)(ws + WS_XBUF), (unsigned*)(ws + WS_CNT)};
                  gemm_phase(lds, g, S, E); }
              else { EpiLnT<2, true> E{(bf16_t*)(ws + WS_T + (size_t)32 * 1024 * 1024), nullptr, nullptr, nullptr, nullptr, nullptr, nullptr, mods, MOD_OFF(1, 1, 2), -1, P.ln_g + 3 * 1024, P.ln_b + 3 * 1024, P.out + O_Y, hA, (unsigned long long*)(ws + WS_XBUF), (unsigned*)(ws + WS_CNT) + 2048};
                  gemm_phase(lds, g, S, E); } }
            skinny3((LAS float*)lds, act + (size_t)MP * DFF, DFF, (const bf16_t*)(ws + WS_DOWN) + (size_t)layer * 1024 * DFF, 1024, raw, G - 1 - bx, G);
            if (G == 256) { sample_gate(P, layer ? 2 : 0); ln_phase(P, layer, 1, 1, 1, P.out + O_Y + (size_t)MP * 1024, layer ? -1 : MOD_OFF(1, 0, 0), false); }
        } if (layer == 0 || G != 256) SEAM(pb + 2);
        if (G != 256 && IN(pb + 3)) for (int rep_ = 0; rep_ < 1 + (int)((REPMASK >> (pb + 3)) & 1u); ++rep_) { if (rep_) GBAR(); PHASE_VARS ln_phase(P, layer, 1, 1, 1, P.out + O_Y + (size_t)MP * 1024, layer ? -1 : MOD_OFF(1, 0, 0), false); }
        if (layer == 0 && G != 256) SEAM(pb + 3);
        if (layer == 0) {
            if (IN(11)) for (int rep_ = 0; rep_ < 1 + (int)((REPMASK >> (11)) & 1u); ++rep_) { if (rep_) GBAR(); PHASE_VARS
                { Gemm g{hA, (const bf16_t*)(ws + WS_SCIN) + (size_t)1024 * 1024, 1024, 1024, 1024}; StaticOrder S; S.init(MP, 2048, G, bx); EpiCv E{(bf16_t*)(ws + WS_BIG)}; gemm_phase(lds, g, S, E); }
                { Gemm g{hA, (const bf16_t*)(ws + WS_SCIN), 1024, 1024, 1024}; StaticOrder S; S.init(MP, 1024, G, bx); EpiGateB E{(bf16_t*)(ws + WS_BIG)}; gemm_phase(lds, g, S, E); }
                skinny3((LAS float*)lds, hA + (size_t)MP * 1024, 1024, (const bf16_t*)(ws + WS_SCIN), 3072, raw, G - 1 - bx, G);
            } SEAM(11);
            if (IN(12)) for (int rep_ = 0; rep_ < 1 + (int)((REPMASK >> (12)) & 1u); ++rep_) { if (rep_) GBAR(); PHASE_VARS shortconv_phase(P); } SEAM(12);
            if (IN(13)) for (int rep_ = 0; rep_ < 1 + (int)((REPMASK >> (13)) & 1u); ++rep_) { if (rep_) GBAR(); PHASE_VARS
                { Gemm g{hA, (const bf16_t*)(ws + WS_SCOUT), 1024, 1024, 1024}; StaticOrder S; S.init(MP, 1024, G, bx);
                  EpiLnT<2, false> E{(bf16_t*)(ws + WS_T + (size_t)32 * 1024 * 1024), (bf16_t*)(ws + WS_T + (size_t)32 * 1024 * 1024), nullptr, nullptr, nullptr, nullptr, nullptr, mods, MOD_OFF(1, 0, 2), MOD_OFF(1, 1, 0), P.ln_g + 2 * 1024, P.ln_b + 2 * 1024, P.out + O_Y, hA, (unsigned long long*)(ws + WS_XBUF), (unsigned*)(ws + WS_CNT) + 1024};
                  gemm_phase(lds, g, S, E); }
                skinny3((LAS float*)lds, hA + (size_t)MP * 1024, 1024, (const bf16_t*)(ws + WS_SCOUT), 1024, raw, G - 1 - bx, G);
                if (G == 256) { sample_gate(P, 1); ln_phase(P, 1, 0, 1, 1, P.out + O_Y + (size_t)MP * 1024, MOD_OFF(1, 1, 0), false); }
            } SEAM(13);
            if (G != 256 && IN(14)) for (int rep_ = 0; rep_ < 1 + (int)((REPMASK >> (14)) & 1u); ++rep_) { if (rep_) GBAR(); PHASE_VARS ln_phase(P, 1, 0, 1, 1, P.out + O_Y + (size_t)MP * 1024, MOD_OFF(1, 1, 0), false); } if (G != 256) SEAM(14);
        }
    }
}

extern "C" void kernel_launch(void* const* d_in, const int* in_sizes, int n_in, void* d_out, int out_size, void* d_ws, size_t ws_size, hipStream_t stream) {
    static int grid = 0;
    if (grid == 0) {
        if (n_in != 29 || (size_t)out_size != O_END || ws_size < WS_END) { fprintf(stderr, "kernel_launch: unexpected shapes: n_in %d out %d ws %zu (need %zu)\n", n_in, out_size, ws_size, (size_t)WS_END); grid = -1; return; }
        int dev = 0, cus = 0, per_cu = 0;
        hipGetDevice(&dev); hipDeviceGetAttribute(&cus, hipDeviceAttributeMultiprocessorCount, dev);
        if (hipFuncSetAttribute((const void*)fwd_kernel, hipFuncAttributeMaxDynamicSharedMemorySize, LDS_BYTES) != hipSuccess) { fprintf(stderr, "kernel_launch: hipFuncSetAttribute failed\n"); grid = -1; return; }
        if (hipOccupancyMaxActiveBlocksPerMultiprocessor(&per_cu, (const void*)fwd_kernel, NTHR, LDS_BYTES) != hipSuccess || per_cu < 1) { fprintf(stderr, "kernel_launch: occupancy query gives %d\n", per_cu); per_cu = 1; }
        (void)hipGetLastError();
        grid = cus;
    }
    if (grid < 0) return;
    Params p{};
    const float** pp = (const float**)&p;
    for (int i = 0; i < 29; ++i) pp[i] = (const float*)d_in[i];
    p.out = (float*)d_out; p.ws = (unsigned char*)d_ws;
#if ONE_LAUNCH
    p.ph_lo = 0; p.ph_hi = NPHASE;
    if (hipMemsetAsync((char*)d_ws + WS_BAR, 0, 32768, stream) != hipSuccess) { fprintf(stderr, "kernel_launch: memset of the barrier word failed\n"); return; }
    void* args[] = {&p};
    hipError_t e = hipLaunchCooperativeKernel((const void*)fwd_kernel, dim3(grid), dim3(NTHR), args, LDS_BYTES, stream);
    if (e != hipSuccess) fprintf(stderr, "cooperative launch failed: %s (grid %d)\n", hipGetErrorString(e), grid);
#else
    for (int ph = 0; ph < NPHASE; ++ph) { p.ph_lo = ph; p.ph_hi = ph + 1; hipLaunchKernelGGL(fwd_kernel, dim3(grid), dim3(NTHR), LDS_BYTES, stream, p); }
#endif
}
```

```cpp
#include <hip/hip_runtime.h>
#include <hip/hip_cooperative_groups.h>
#include <cstdio>
namespace cg = cooperative_groups;

#ifndef ONE_LAUNCH
#define ONE_LAUNCH 1
#endif

#ifndef REPMASK
#define REPMASK 0u
#endif
#ifndef SKREP
#define SKREP 1
#endif
#ifndef S5P_REP
#define S5P_REP 1
#endif
#ifndef S5S_REP
#define S5S_REP 1
#endif
#ifndef XSYNC
#define XSYNC 0
#endif
#define LAS __attribute__((address_space(3)))
typedef unsigned short bf16_t;
typedef short bf16x8 __attribute__((ext_vector_type(8)));
typedef float f32x4 __attribute__((ext_vector_type(4)));
typedef unsigned u32x4 __attribute__((ext_vector_type(4)));
typedef unsigned u32x2 __attribute__((ext_vector_type(2)));

constexpr int D = 1024, SEQ = 2048, NB = 8, MP = NB * SEQ, NS = 128, MT = MP + NS;
constexpr int DFF = 2816, DFF2 = 5632, NMOD = 12288;
constexpr float ALPHA = 1.41421356237309515f;
constexpr float LN_EPS = 1e-5f;
constexpr int NTHR = 512;
constexpr int LDS_BYTES = 131072 + 2048;
constexpr int NPHASE = 19;

constexpr size_t WS_WIN = 0;
constexpr size_t WS_WGLU = WS_WIN + (size_t)1024 * 1024 * 2;
constexpr size_t WS_SCIN = WS_WGLU + (size_t)2048 * 1024 * 2;
constexpr size_t WS_SCOUT = WS_SCIN + (size_t)3072 * 1024 * 2;
constexpr size_t WS_UP = WS_SCOUT + (size_t)1024 * 1024 * 2;
constexpr size_t WS_DOWN = WS_UP + (size_t)2 * 5632 * 1024 * 2;
constexpr size_t WS_H = WS_DOWN + (size_t)2 * 1024 * 2816 * 2;
constexpr size_t WS_T = WS_H + (size_t)MT * 1024 * 2;
constexpr size_t WS_BIG = WS_T + (size_t)MT * 1024 * 4;
constexpr size_t BIG_TAB1 = 0;
constexpr size_t BIG_TAB2 = BIG_TAB1 + (size_t)64 * 128 * 256 * 2;
constexpr size_t BIG_SLOC = BIG_TAB2 + (size_t)64 * 256 * 384 * 2;
constexpr size_t BIG_HALO = (size_t)MT * 2816 * 2;
constexpr size_t WS_MODS = WS_BIG + BIG_HALO + (size_t)128 * 4 * 5632 * 2;
constexpr size_t WS_RAW = WS_MODS + (size_t)136 * NMOD * 4;
constexpr size_t WS_AC = WS_RAW + (size_t)4 * 128 * 3072 * 4;
constexpr size_t WS_S5C = WS_AC + (size_t)144 * 1024 * 2;
constexpr size_t WS_BBAR = WS_S5C + (size_t)64 * 64 * 8 * 4;
constexpr size_t WS_BAR = WS_BBAR + (size_t)64 * 64 * 32 * 4;
constexpr size_t WS_CNT = WS_BAR + 16384;
constexpr size_t WS_XBUF = WS_CNT + 16384;
constexpr size_t WS_STATS = WS_XBUF + (size_t)64 * 256 * 4 * 8;
constexpr size_t WS_END = WS_STATS + (size_t)MP * 8;

constexpr size_t O_Y = 0;
constexpr size_t O_S5RE_P = (size_t)MT * 1024;
constexpr size_t O_S5IM_P = O_S5RE_P + 8 * 64 * 64;
constexpr size_t O_S5RE_S = O_S5IM_P + 8 * 64 * 64;
constexpr size_t O_S5IM_S = O_S5RE_S + 128 * 64 * 64;
constexpr size_t O_CONV_P = O_S5IM_S + 128 * 64 * 64;
constexpr size_t O_CONV_S = O_CONV_P + 8 * 2 * 1024;
constexpr size_t O_FFN_P = O_CONV_S + 128 * 2 * 1024;
constexpr size_t O_FFN_S = O_FFN_P + (size_t)2 * 8 * 2 * 5632;
constexpr size_t O_END = O_FFN_S + (size_t)2 * 128 * 2 * 5632;

struct Params {
    const float *x_p, *x_s, *c_p, *c_s, *s5re, *s5im, *st_conv, *st_ffn, *w_ada, *b_ada, *s5_w_in, *lam_re, *lam_im, *log_dt,
        *b_re, *b_im, *c_re, *c_im, *s5_d, *w_glu, *sc_w_in, *sc_conv_w, *sc_w_out, *ffn_w_up, *ffn_conv_w, *ffn_conv_b, *ffn_w_down, *ln_g, *ln_b;
    float* out; unsigned char* ws; int ph_lo, ph_hi;
};
typedef const Params __attribute__((address_space(4))) KP;
__device__ __forceinline__ KP& getP() { KP* p = (KP*)__builtin_amdgcn_kernarg_segment_ptr(); asm volatile("" : "+s"(p)); return *p; }

__device__ __forceinline__ unsigned cvt_pk_bf16(float lo, float hi) { unsigned r; asm volatile("v_cvt_pk_bf16_f32 %0, %1, %2" : "=v"(r) : "v"(lo), "v"(hi)); return r; }
__device__ __forceinline__ float bf2f(unsigned short b) { return __uint_as_float(((unsigned)b) << 16); }
__device__ __forceinline__ float bflo(unsigned w) { return __uint_as_float(w << 16); }
__device__ __forceinline__ float bfhi(unsigned w) { return __uint_as_float(w & 0xffff0000u); }
__device__ __forceinline__ float sigmoidf_(float x) { return __builtin_amdgcn_rcpf(1.0f + __builtin_amdgcn_exp2f(-1.44269504089f * x)); }
__device__ __forceinline__ float gelu_tanh(float x) { const float u = 1.5957691216057308f * (x + 0.044715f * x * x * x); return x * sigmoidf_(u); }
typedef float f32x2 __attribute__((ext_vector_type(2)));
__device__ __forceinline__ f32x2 gelu2(f32x2 x) {
    f32x2 z = x * (x * x * (-0.10294324f) + (-2.302208198f));
    z.x = fminf(z.x, 60.f); z.y = fminf(z.y, 60.f);
    f32x2 d; d.x = __builtin_amdgcn_exp2f(z.x); d.y = __builtin_amdgcn_exp2f(z.y); d = d + 1.0f;
    const float r = __builtin_amdgcn_rcpf(d.x * d.y);
    return x * ((f32x2){d.y, d.x} * r);
}
__device__ __forceinline__ int pcol(int c) { return ((c >> 7) << 8) + (c & 127); }
template <int CTRL> __device__ __forceinline__ float dppx(float x) { return __builtin_bit_cast(float, __builtin_amdgcn_update_dpp(0, __builtin_bit_cast(int, x), CTRL, 0xf, 0xf, false)); }
__device__ __forceinline__ float wave_sum(float v) {
    v += dppx<0xB1>(v); v += dppx<0x4E>(v); v += dppx<0x141>(v); v += dppx<0x140>(v);
    v += __shfl_xor(v, 16); v += __shfl_xor(v, 32);
    return v;
}
template <int CTRL> __device__ __forceinline__ float dppf(float x) { return __builtin_bit_cast(float, __builtin_amdgcn_update_dpp(0, __builtin_bit_cast(int, x), CTRL, 0xf, 0xf, false)); }

extern __shared__ __attribute__((aligned(16))) unsigned char lds_raw[];
constexpr int LDS_WTAB = 131072 + 256;
__device__ __forceinline__ int ltid() {
    const unsigned slot = (unsigned)__builtin_amdgcn_s_getreg((5 << 11) | 4) & 63u;
    const int w = __builtin_amdgcn_readfirstlane(((volatile LAS int*)((LAS unsigned char*)lds_raw + LDS_WTAB))[slot]);
    int ln_; asm volatile("v_mbcnt_lo_u32_b32 %0, -1, 0\n\tv_mbcnt_hi_u32_b32 %0, -1, %0" : "=v"(ln_));
    int t = (w << 6) | ln_;
    asm volatile("" : "+v"(t));
    return t;
}
__device__ __forceinline__ void cis_d(double x, double& s, double& c) {
    const double k = rint(x * 0.63661977236758134308);
    double r = fma(-k, 1.57079632679489655800e+00, x); r = fma(-k, 6.12323399573676603587e-17, r);
    const double r2 = r * r;
    const double sp = r * (1.0 + r2 * (-1.0 / 6.0 + r2 * (1.0 / 120.0 + r2 * (-1.0 / 5040.0 + r2 * (1.0 / 362880.0 + r2 * (-1.0 / 39916800.0 + r2 * (1.0 / 6227020800.0)))))));
    const double cp = 1.0 + r2 * (-0.5 + r2 * (1.0 / 24.0 + r2 * (-1.0 / 720.0 + r2 * (1.0 / 40320.0 + r2 * (-1.0 / 3628800.0 + r2 * (1.0 / 479001600.0 + r2 * (-1.0 / 87178291200.0)))))));
    const int q = ((int)k) & 3;
    s = (q == 0) ? sp : (q == 1) ? cp : (q == 2) ? -sp : -cp;
    c = (q == 0) ? cp : (q == 1) ? -sp : (q == 2) ? -cp : sp;
}
__device__ __forceinline__ void apow_d(KP& P, int g, int p, double e, double& ar, double& ai) {
    const double lr = (double)P.lam_re[g * 64 + p], li = (double)P.lam_im[g * 64 + p], dt = exp((double)P.log_dt[g]);
    const double mag = exp(e * lr * dt); double s, c; cis_d(e * li * dt, s, c); ar = mag * c; ai = mag * s;
}
__device__ __forceinline__ void bcoef_d(KP& P, int g, int p, double& cr, double& ci) {
    const double lr = (double)P.lam_re[g * 64 + p], li = (double)P.lam_im[g * 64 + p];
    double ar, ai; apow_d(P, g, p, 1.0, ar, ai);
    const double nr = ar - 1.0, ni = ai, den = lr * lr + li * li;
    cr = (nr * lr + ni * li) / den; ci = (ni * lr - nr * li) / den;
}

constexpr int BM = 256, BK = 64, HALF = 128, HTB = HALF * BK * 2, NXCD = 8, WGM = 4;
__device__ __forceinline__ int lds_byte(int r, int c) { const int st = (r >> 4) * 2 + (c >> 5), rr = r & 15, cc = c & 31, ob = rr * 64 + cc * 2; return st * 1024 + (ob ^ (((ob >> 9) & 1) << 5)); }
__device__ __forceinline__ void stage_rc(int b, int& R, int& C) { const int st = b / 1024, sb = b % 1024, swz = sb ^ (((sb >> 9) & 1) << 5); R = (st >> 1) * 16 + swz / 64; C = (st & 1) * 32 + (swz % 64) / 2; }
__device__ __forceinline__ int perm32(int rho) { const int n = rho >> 4, i = rho & 15; return 8 * (i >> 2) + 4 * n + (i & 3); }

struct Unit { int pm, pn; };
struct Gemm { const bf16_t* A; const bf16_t* Bt; int lda, ldb, K; };
struct StaticOrder {
    int nM, nN, nwg, G, c, wg;
    __device__ __forceinline__ void init(int M, int N, int G_, int c_) { nM = M / BM; nN = N / BM; nwg = nM * nN; G = G_; c = c_; wg = (nN == 8) ? 1 : (nN > 12 ? 2 : (nN == 4 ? 2 : WGM)); }
    __device__ __forceinline__ bool next(int i, Unit& u) const {
        const long L = (long)i * G + c; if (L >= nwg) return false;
        int wgid = (int)L; { const int q = nwg / NXCD, r = nwg % NXCD, xcd = wgid % NXCD, off = wgid / NXCD; wgid = (xcd < r ? xcd * (q + 1) : r * (q + 1) + (xcd - r) * q) + off; }
        const int nig = wg * nN, gid = wgid / nig, fm = gid * wg, gsz = (nM - fm) < wg ? (nM - fm) : wg;
        u.pm = fm + ((wgid % nig) % gsz); u.pn = (wgid % nig) / gsz; return true;
    }
};
struct OneUnit { Unit u; __device__ __forceinline__ bool next(int i, Unit& o) const { if (i) return false; o = u; return true; } };

template <class Epi, class Sched>
__device__ __forceinline__ void gemm_phase(LAS unsigned char* lds, const Gemm g, const Sched& S, Epi& E) {
    const int tid = ltid(), wid = __builtin_amdgcn_readfirstlane(tid >> 6), lane = tid & 63, wr = wid >> 2, wc = wid & 3, fr = lane & 15, fq = lane >> 4;
    const int K = g.K, nt = K / BK;
    unsigned voffA[2], voffB[2];
#pragma unroll
    for (int i = 0; i < 2; ++i) { int R, C; stage_rc(tid * 16 + i * 8192, R, C); const int Rb = Epi::PERM ? ((R & ~31) + perm32(R & 31)) : R; const int Ra = Epi::RPERM ? (R + 64 * (R >> 6)) : R;
        voffA[i] = (Epi::AMODE == 1) ? (unsigned)((C >> 4) * (MP * 16) + Ra * 16 + (C & 15)) * 2u : (unsigned)(Ra * g.lda + C) * 2u; voffB[i] = (unsigned)(Rb * g.ldb + C) * 2u; }
    const size_t kstep = (size_t)(BK * 2);
    const size_t kstepA = (Epi::AMODE == 1) ? (size_t)4 * MP * 16 * 2 : kstep;
    const size_t hstepA = (Epi::AMODE == 1) ? (size_t)128 * 16 * 2 : (size_t)(Epi::RPERM ? 64 : 128) * g.lda * 2, hstepB = (size_t)HALF * g.ldb * 2;
    const size_t tstepA = (Epi::AMODE == 1) ? (size_t)BM * 16 * 2 : (size_t)BM * g.lda * 2, tstepB = (size_t)BM * g.ldb * 2;
    const unsigned ldsw = (unsigned)wid * 1024u;
    const int aoff = lds_byte(wr * 64 + fr, fq * 8), boff = lds_byte(wc * 32 + fr, fq * 8);
#define PG8_SA(b, h) (((b) * 2 + (h)) * HTB)
#define PG8_SB(b, h) ((4 + (b) * 2 + (h)) * HTB)
#define PG8_STAGE(bufoff, gbase, voff) do { _Pragma("unroll") for (int _i = 0; _i < 2; ++_i) \
        __builtin_amdgcn_global_load_lds((const unsigned*)((const char*)(gbase) + (voff)[_i]), (LAS unsigned*)(lds + (bufoff) + ldsw + _i * 8192), 16, 0, 0); } while (0)
#define PG8_LDA(dst, b, h) do { _Pragma("unroll") for (int m = 0; m < 4; ++m) _Pragma("unroll") for (int k = 0; k < 2; ++k) dst[m][k] = *(const LAS bf16x8*)(lds + PG8_SA(b, h) + aoff + m * 2048 + k * 1024); } while (0)
#define PG8_LDB(dst, b, h) do { _Pragma("unroll") for (int n = 0; n < 2; ++n) _Pragma("unroll") for (int k = 0; k < 2; ++k) dst[n][k] = *(const LAS bf16x8*)(lds + PG8_SB(b, h) + boff + n * 2048 + k * 1024); } while (0)
#define PG8_MMA(ai, bj, At, Bt) do { __builtin_amdgcn_s_setprio(1); _Pragma("unroll") for (int m = 0; m < 4; ++m) _Pragma("unroll") for (int n = 0; n < 2; ++n) _Pragma("unroll") for (int k = 0; k < 2; ++k) \
        acc[ai][bj][m][n] = __builtin_amdgcn_mfma_f32_16x16x32_bf16(Bt[n][k], At[m][k], acc[ai][bj][m][n], 0, 0, 0); __builtin_amdgcn_s_setprio(0); } while (0)
#define PG8_WAIT_V(n) asm volatile("s_waitcnt vmcnt(" #n ")" ::: "memory")
#define PG8_WAIT_L(n) asm volatile("s_waitcnt lgkmcnt(" #n ")" ::: "memory")
#define PG8_BAR __builtin_amdgcn_s_barrier()
#define PG8_SCHED __builtin_amdgcn_sched_barrier(0)
    Unit cur, nxt; int ui = 0;
    if (!S.next(0, cur)) return;
    f32x4 acc[2][2][4][2];
#pragma unroll
    for (int a = 0; a < 2; ++a)
#pragma unroll
        for (int b = 0; b < 2; ++b)
#pragma unroll
            for (int m = 0; m < 4; ++m)
#pragma unroll
                for (int n = 0; n < 2; ++n) acc[a][b][m][n] = (f32x4){0.f, 0.f, 0.f, 0.f};
    bf16x8 At[4][2], B0[2][2], B1[2][2];
    const char* cA = (const char*)g.A + (size_t)cur.pm * tstepA; const char* cB = (const char*)g.Bt + (size_t)cur.pn * tstepB;
    PG8_STAGE(PG8_SB(0, 0), cB, voffB); PG8_STAGE(PG8_SA(0, 0), cA, voffA); PG8_STAGE(PG8_SB(0, 1), cB + hstepB, voffB); PG8_STAGE(PG8_SA(0, 1), cA + hstepA, voffA);
    if (wr == 1) PG8_BAR;
    PG8_WAIT_V(4); PG8_BAR;
    PG8_STAGE(PG8_SB(1, 0), cB + kstep, voffB); PG8_STAGE(PG8_SA(1, 0), cA + kstepA, voffA); PG8_STAGE(PG8_SB(1, 1), cB + hstepB + kstep, voffB);
    PG8_WAIT_V(6); PG8_BAR;
    for (;;) {
        const bool has_next = S.next(ui + 1, nxt);
        const char* nA = has_next ? (const char*)g.A + (size_t)nxt.pm * tstepA : cA; const char* nB = has_next ? (const char*)g.Bt + (size_t)nxt.pn * tstepB : cB;
        for (int t = 0; t < nt; t += 2) {
            const bool last = (t == nt - 2);
            const char* a1 = cA + (size_t)(t + 1) * kstepA;
            const char* a2 = last ? nA : cA + (size_t)(t + 2) * kstepA; const char* b2 = last ? nB : cB + (size_t)(t + 2) * kstep;
            const char* a3 = a2 + kstepA; const char* b3 = b2 + kstep;
            PG8_LDB(B0, 0, 0); PG8_SCHED; PG8_LDA(At, 0, 0); PG8_STAGE(PG8_SA(1, 1), a1 + hstepA, voffA);
            PG8_WAIT_L(8); PG8_BAR; PG8_WAIT_L(0); PG8_MMA(0, 0, At, B0); PG8_BAR; PG8_SCHED;
            PG8_LDB(B1, 0, 1); PG8_STAGE(PG8_SB(0, 0), b2, voffB);
            PG8_BAR; PG8_WAIT_L(0); PG8_MMA(0, 1, At, B1); PG8_BAR;
            PG8_LDA(At, 0, 1); PG8_STAGE(PG8_SA(0, 0), a2, voffA);
            PG8_BAR; PG8_WAIT_L(0); PG8_MMA(1, 0, At, B0); PG8_BAR; PG8_SCHED;
            PG8_STAGE(PG8_SB(0, 1), b2 + hstepB, voffB);
            PG8_WAIT_V(6); PG8_BAR; PG8_MMA(1, 1, At, B1); PG8_BAR;
            PG8_LDB(B0, 1, 0); PG8_SCHED; PG8_LDA(At, 1, 0); PG8_STAGE(PG8_SA(0, 1), a2 + hstepA, voffA);
            PG8_WAIT_L(8); PG8_BAR; PG8_WAIT_L(0); PG8_MMA(0, 0, At, B0); PG8_BAR; PG8_SCHED;
            PG8_LDB(B1, 1, 1); PG8_STAGE(PG8_SB(1, 0), b3, voffB);
            PG8_BAR; PG8_WAIT_L(0); PG8_MMA(0, 1, At, B1); PG8_BAR;
            PG8_LDA(At, 1, 1); PG8_STAGE(PG8_SA(1, 0), a3, voffA);
            PG8_BAR; PG8_WAIT_L(0); PG8_MMA(1, 0, At, B0); PG8_BAR; PG8_SCHED;
            PG8_STAGE(PG8_SB(1, 1), b3 + hstepB, voffB);
            PG8_WAIT_V(6); PG8_BAR; PG8_MMA(1, 1, At, B1); PG8_BAR;
        }
        if constexpr (!Epi::AFTER_DRAIN) E(acc, cur, wr, wc, fr, fq);
        if (!has_next) break;
#pragma unroll
        for (int a = 0; a < 2; ++a)
#pragma unroll
            for (int b = 0; b < 2; ++b)
#pragma unroll
                for (int m = 0; m < 4; ++m)
#pragma unroll
                    for (int n = 0; n < 2; ++n) acc[a][b][m][n] = (f32x4){0.f, 0.f, 0.f, 0.f};
        cur = nxt; cA = nA; cB = nB; ++ui;
    }
    PG8_WAIT_V(0);
    if (wr == 0) PG8_BAR;
    PG8_BAR;
    if constexpr (Epi::AFTER_DRAIN) E.fused(acc, cur, wr, wc, fr, fq, lds, wid, lane);
#undef PG8_SA
#undef PG8_SB
#undef PG8_STAGE
#undef PG8_LDA
#undef PG8_LDB
#undef PG8_MMA
#undef PG8_WAIT_V
#undef PG8_WAIT_L
#undef PG8_BAR
#undef PG8_SCHED
}

typedef f32x4 AccT[2][2][4][2];
__device__ __forceinline__ u32x4 pack8(const f32x4 a, const f32x4 b) { u32x4 w; w.x = cvt_pk_bf16(a[0], a[1]); w.y = cvt_pk_bf16(a[2], a[3]); w.z = cvt_pk_bf16(b[0], b[1]); w.w = cvt_pk_bf16(b[2], b[3]); return w; }

struct EpiWin {
    static constexpr bool PERM = true, RPERM = false, AFTER_DRAIN = false; static constexpr int AMODE = 0;
    bf16_t* A2;
    __device__ __forceinline__ void operator()(AccT& acc, const Unit& u, int wr, int wc, int fr, int fq) const {
#pragma unroll
        for (int ai = 0; ai < 2; ++ai)
#pragma unroll
            for (int m = 0; m < 4; ++m) { const int rc = u.pm * 16 + ai * 8 + wr * 4 + m;
#pragma unroll
                for (int bj = 0; bj < 2; ++bj) { const int colb = u.pn * 256 + bj * 128 + wc * 32 + 8 * fq, g = colb >> 4, c0 = colb & 15;
                    *(u32x4*)(A2 + ((size_t)(g * 1024 + rc) * 384 + fr * 16 + c0)) = pack8(acc[ai][bj][m][0], acc[ai][bj][m][1]); }
                asm volatile("" ::: "memory"); }
    }
};
struct EpiS1 {
    static constexpr bool PERM = false, RPERM = false, AFTER_DRAIN = false; static constexpr int AMODE = 0;
    float* Sl;
    __device__ __forceinline__ void operator()(AccT& acc, const Unit& u, int wr, int wc, int fr, int fq) const {
#pragma unroll
        for (int ai = 0; ai < 2; ++ai)
#pragma unroll
            for (int m = 0; m < 4; ++m) { const int row = u.pm * 256 + ai * 128 + wr * 64 + m * 16 + fr;
#pragma unroll
                for (int n = 0; n < 2; ++n) *(f32x4*)(Sl + (size_t)row * 128 + wc * 32 + n * 16 + 4 * fq) = acc[ai][0][m][n]; }
    }
};
struct EpiS2 {
    static constexpr bool PERM = true, RPERM = false, AFTER_DRAIN = false; static constexpr int AMODE = 0;
    const bf16_t* A2g; const float* dsk; bf16_t* hA; int g;
    __device__ __forceinline__ void operator()(AccT& acc, const Unit& u, int wr, int wc, int fr, int fq) const {
        const int colb = wc * 32 + 8 * fq, rcb = u.pm * 256 + wr * 64 + fr;
        f32x4 d[2][2];
#pragma unroll
        for (int bj = 0; bj < 2; ++bj) { const int c0 = (bj * 128 + colb) & 15; d[bj][0] = *(const f32x4*)(dsk + g * 16 + c0); d[bj][1] = *(const f32x4*)(dsk + g * 16 + c0 + 4); }
        u32x4 uw[2];
        uw[0] = *(const u32x4*)(A2g + (size_t)rcb * 384 + colb);
#pragma unroll
        for (int st = 0; st < 16; ++st) { const int bj = st >> 3, ai = (st >> 2) & 1, m = st & 3;
            if (st + 1 < 16) { const int nb = (st + 1) >> 3, na = ((st + 1) >> 2) & 1, nm = (st + 1) & 3; uw[(st + 1) & 1] = *(const u32x4*)(A2g + (size_t)(rcb + na * 128 + nm * 16) * 384 + nb * 128 + colb); }
            asm volatile("" ::: "memory");
            const int col = bj * 128 + colb, l = col >> 4, c0 = col & 15, rc = rcb + ai * 128 + m * 16; const u32x4 w = uw[st & 1];
            f32x4 a = acc[ai][bj][m][0], b = acc[ai][bj][m][1];
            a[0] += d[bj][0][0] * bflo(w.x); a[1] += d[bj][0][1] * bfhi(w.x); a[2] += d[bj][0][2] * bflo(w.y); a[3] += d[bj][0][3] * bfhi(w.y);
            b[0] += d[bj][1][0] * bflo(w.z); b[1] += d[bj][1][1] * bfhi(w.z); b[2] += d[bj][1][2] * bflo(w.w); b[3] += d[bj][1][3] * bfhi(w.w);
#pragma unroll
            for (int j = 0; j < 4; j += 2) { const f32x2 ga = gelu2((f32x2){a[j], a[j + 1]}), gb = gelu2((f32x2){b[j], b[j + 1]}); a[j] = ga.x; a[j + 1] = ga.y; b[j] = gb.x; b[j + 1] = gb.y; }
            u32x4 o = pack8(a, b); asm volatile("" : "+v"(o));
            *(u32x4*)(hA + ((size_t)g * MP + rc * 16 + l) * 16 + c0) = o; }
    }
};

struct EpiGlu {
    static constexpr bool PERM = false, RPERM = false, AFTER_DRAIN = false; static constexpr int AMODE = 1;
    const float* xres; const float* gmod; bf16_t* T;
    __device__ __forceinline__ void operator()(AccT& acc, const Unit& u, int wr, int wc, int fr, int fq) const {
        const int ns = u.pm >> 3, colb = u.pn * 128 + wc * 32 + 4 * fq, rowb = u.pm * 256 + wr * 64 + fr;
        f32x4 gm[2], xr[2][2];
#pragma unroll
        for (int n = 0; n < 2; ++n) { gm[n] = *(const f32x4*)(gmod + (size_t)ns * NMOD + colb + n * 16); xr[0][n] = *(const f32x4*)(xres + (size_t)rowb * 1024 + colb + n * 16); }
#pragma unroll
        for (int st = 0; st < 8; ++st) { const int ai = st >> 2, m = st & 3, row = rowb + ai * 128 + m * 16;
            if (st + 1 < 8) { const int nrow = rowb + ((st + 1) >> 2) * 128 + ((st + 1) & 3) * 16;
#pragma unroll
                for (int n = 0; n < 2; ++n) xr[(st + 1) & 1][n] = *(const f32x4*)(xres + (size_t)nrow * 1024 + colb + n * 16); }
            asm volatile("" ::: "memory");
#pragma unroll
            for (int n = 0; n < 2; ++n) { const f32x4 v = acc[ai][0][m][n], gt = acc[ai][1][m][n], x = xr[st & 1][n]; f32x4 o;
#pragma unroll
                for (int j = 0; j < 4; ++j) o[j] = ALPHA * x[j] + gm[n][j] * (v[j] * sigmoidf_(gt[j]));
                u32x2 w; w.x = cvt_pk_bf16(o[0], o[1]); w.y = cvt_pk_bf16(o[2], o[3]); asm volatile("" : "+v"(w));
                *(u32x2*)(T + (size_t)row * 1024 + colb + n * 16) = w; } }
    }
};

struct EpiT {
    static constexpr bool PERM = false, RPERM = false, AFTER_DRAIN = false; static constexpr int AMODE = 0;
    const float* xres; const float* gmod; float* T;
    __device__ __forceinline__ void operator()(AccT& acc, const Unit& u, int wr, int wc, int fr, int fq) const {
#pragma unroll
        for (int ai = 0; ai < 2; ++ai)
#pragma unroll
            for (int m = 0; m < 4; ++m) { const int row = u.pm * 256 + ai * 128 + wr * 64 + m * 16 + fr; const int ns = row >> 11;
#pragma unroll
                for (int bj = 0; bj < 2; ++bj)
#pragma unroll
                    for (int n = 0; n < 2; ++n) { const int col = u.pn * 256 + bj * 128 + wc * 32 + n * 16 + 4 * fq;
                        const f32x4 xr = *(const f32x4*)(xres + (size_t)row * 1024 + col), gm = *(const f32x4*)(gmod + (size_t)ns * NMOD + col);
                        *(f32x4*)(T + (size_t)row * 1024 + col) = ALPHA * xr + gm * acc[ai][bj][m][n]; }
                asm volatile("" ::: "memory"); }
    }
};
struct EpiGateB {
    static constexpr bool PERM = true, RPERM = false, AFTER_DRAIN = false; static constexpr int AMODE = 0;
    bf16_t* z2;
    __device__ __forceinline__ void operator()(AccT& acc, const Unit& u, int wr, int wc, int fr, int fq) const {
#pragma unroll
        for (int ai = 0; ai < 2; ++ai)
#pragma unroll
            for (int m = 0; m < 4; ++m) { const int row = u.pm * 256 + ai * 128 + wr * 64 + m * 16 + fr;
#pragma unroll
                for (int bj = 0; bj < 2; ++bj) *(u32x4*)(z2 + (size_t)row * 2048 + u.pn * 256 + bj * 128 + wc * 32 + 8 * fq) = pack8(acc[ai][bj][m][0], acc[ai][bj][m][1]);
                asm volatile("" ::: "memory"); }
    }
};
struct EpiCv {
    static constexpr bool PERM = true, RPERM = false, AFTER_DRAIN = false; static constexpr int AMODE = 0;
    bf16_t* z2;
    __device__ __forceinline__ void operator()(AccT& acc, const Unit& u, int wr, int wc, int fr, int fq) const {
#pragma unroll
        for (int ai = 0; ai < 2; ++ai)
#pragma unroll
            for (int m = 0; m < 4; ++m) { const int row = u.pm * 256 + ai * 128 + wr * 64 + m * 16 + fr;
                *(u32x4*)(z2 + (size_t)row * 2048 + 1024 + u.pn * 128 + wc * 32 + 8 * fq) = pack8(acc[ai][0][m][0] * acc[ai][1][m][0], acc[ai][0][m][1] * acc[ai][1][m][1]);
                asm volatile("" ::: "memory"); }
    }
};
struct EpiUp {
    static constexpr bool PERM = true, RPERM = true, AFTER_DRAIN = false; static constexpr int AMODE = 0;
    bf16_t* act; bf16_t* halo; float* ffn_out; const float* cw; const float* cb;
    __device__ __forceinline__ void operator()(AccT& acc, const Unit& u, int wr, int wc, int fr, int fq) const {
        const int vcol = u.pn * 128 + wc * 32 + 8 * fq, blk = u.pm * 2 + wr;
        asm volatile("" ::: "memory"); __builtin_amdgcn_sched_barrier(0);
        if (fr < 2) {
#pragma unroll
            for (int bj = 0; bj < 2; ++bj) *(u32x4*)(halo + (size_t)(blk * 4 + fr) * DFF2 + bj * DFF + vcol) = pack8(acc[0][bj][0][0], acc[0][bj][0][1]);
        }
        if (fr >= 14) {
#pragma unroll
            for (int bj = 0; bj < 2; ++bj) { *(u32x4*)(halo + (size_t)(blk * 4 + 2 + (fr - 14)) * DFF2 + bj * DFF + vcol) = pack8(acc[1][bj][3][0], acc[1][bj][3][1]);
                if ((u.pm & 7) == 7 && wr == 1) { float* o = ffn_out + (size_t)((u.pm >> 3) * 2 + (fr - 14)) * DFF2 + bj * DFF + vcol; *(f32x4*)o = acc[1][bj][3][0]; *(f32x4*)(o + 4) = acc[1][bj][3][1]; } }
        }
        asm volatile("" ::: "memory"); __builtin_amdgcn_sched_barrier(0);
        f32x4 wq[2][4];
        { const int col = vcol; wq[0][0] = *(const f32x4*)(cw + col); wq[0][1] = *(const f32x4*)(cw + DFF2 + col); wq[0][2] = *(const f32x4*)(cw + 2 * DFF2 + col); wq[0][3] = *(const f32x4*)(cb + col); }
#pragma unroll
        for (int gi = 0; gi < 4; ++gi) { const int bj = gi >> 1, n = gi & 1;
            if (gi + 1 < 4) { const int col = ((gi + 1) >> 1) * DFF + vcol + 4 * ((gi + 1) & 1);
                wq[(gi + 1) & 1][0] = *(const f32x4*)(cw + col); wq[(gi + 1) & 1][1] = *(const f32x4*)(cw + DFF2 + col); wq[(gi + 1) & 1][2] = *(const f32x4*)(cw + 2 * DFF2 + col); wq[(gi + 1) & 1][3] = *(const f32x4*)(cb + col); }
            asm volatile("" ::: "memory");
            const f32x4 w0 = wq[gi & 1][0], w1 = wq[gi & 1][1], w2 = wq[gi & 1][2], bb = wq[gi & 1][3];
            f32x4 w1c, w1p, w0c, w0p;
#pragma unroll
            for (int j = 0; j < 4; ++j) { w1c[j] = (fr == 0) ? 0.f : w1[j]; w1p[j] = (fr == 0) ? w1[j] : 0.f; w0c[j] = (fr < 2) ? 0.f : w0[j]; w0p[j] = (fr < 2) ? w0[j] : 0.f; }
#pragma unroll
            for (int rg = 7; rg >= 0; --rg) { const int ai = rg >> 2, m = rg & 3, pi = (rg ? rg - 1 : 0) >> 2, pmm = (rg ? rg - 1 : 0) & 3;
                const f32x4 cur = acc[ai][bj][m][n], prev = acc[pi][bj][pmm][n]; f32x4 r;
#pragma unroll
                for (int j = 0; j < 4; ++j) { float t = w2[j] * cur[j] + bb[j];
                    asm volatile("s_nop 1\n\tv_fmac_f32_dpp %0, %1, %2 row_ror:1 row_mask:0xf bank_mask:0xf" : "+v"(t) : "v"(cur[j]), "v"(w1c[j]));
                    asm volatile("v_fmac_f32_dpp %0, %1, %2 row_ror:1 row_mask:0xf bank_mask:0xf" : "+v"(t) : "v"(prev[j]), "v"(w1p[j]));
                    asm volatile("v_fmac_f32_dpp %0, %1, %2 row_ror:2 row_mask:0xf bank_mask:0xf" : "+v"(t) : "v"(cur[j]), "v"(w0c[j]));
                    asm volatile("v_fmac_f32_dpp %0, %1, %2 row_ror:2 row_mask:0xf bank_mask:0xf" : "+v"(t) : "v"(prev[j]), "v"(w0p[j]));
                    r[j] = t; }
                acc[ai][bj][m][n] = r; } }
#pragma unroll
        for (int rg = 0; rg < 8; ++rg) { const int ai = rg >> 2, m = rg & 3; const int row = u.pm * 256 + wr * 128 + rg * 16 + fr;
            f32x4 a, b;
#pragma unroll
            for (int j = 0; j < 4; j += 2) { const f32x2 ga = gelu2((f32x2){acc[ai][1][m][0][j], acc[ai][1][m][0][j + 1]}), gb = gelu2((f32x2){acc[ai][1][m][1][j], acc[ai][1][m][1][j + 1]});
                a[j] = ga.x * acc[ai][0][m][0][j]; a[j + 1] = ga.y * acc[ai][0][m][0][j + 1]; b[j] = gb.x * acc[ai][0][m][1][j]; b[j + 1] = gb.y * acc[ai][0][m][1][j + 1]; }
            if (rg != 0 || fr >= 2) *(u32x4*)(act + (size_t)row * DFF + vcol) = pack8(a, b);
            asm volatile("" ::: "memory"); __builtin_amdgcn_sched_barrier(0); }
    }
};

template <int XIN, bool XOUT_F32> struct EpiLnT {
    static constexpr bool XREC = (XIN == 1); const bf16_t* xbi; bf16_t* xbo;
    static constexpr bool PERM = false, RPERM = false, AFTER_DRAIN = true; static constexpr int AMODE = 0;
    const bf16_t* Tb; const float* stats; const float* lg0; const float* lb0;
    const float* xres; const float* mods; int gate_off, next_off; const float* lg; const float* lb; float* xout; bf16_t* hA; unsigned long long* xbuf; unsigned* cnt;
    __device__ __forceinline__ void fused(AccT& acc, const Unit& u, int wr, int wc, int fr, int fq, LAS unsigned char* lds, int wid, int lane) const {
        typedef float f32x2v __attribute__((ext_vector_type(2)));
        const int ns = u.pm >> 3, tid = wid * 64 + lane;
        LAS f32x2v* Pt = (LAS f32x2v*)lds;
        LAS f32x2v* St = (LAS f32x2v*)(lds + 8192);
        if constexpr (XIN == 0) {
            const int colb = u.pn * 256 + wc * 32 + 4 * fq, rowb = u.pm * 256 + wr * 64 + fr;
            f32x4 gm[2][2], xr[2][2][2];
#pragma unroll
            for (int bj = 0; bj < 2; ++bj)
#pragma unroll
                for (int n = 0; n < 2; ++n) { gm[bj][n] = *(const f32x4*)(mods + (size_t)ns * NMOD + gate_off + colb + bj * 128 + n * 16); xr[0][bj][n] = *(const f32x4*)(xres + (size_t)rowb * 1024 + colb + bj * 128 + n * 16); }
#pragma unroll
            for (int st = 0; st < 8; ++st) { const int ai = st >> 2, m = st & 3;
                if (st + 1 < 8) { const int nrow = rowb + ((st + 1) >> 2) * 128 + ((st + 1) & 3) * 16;
#pragma unroll
                    for (int bj = 0; bj < 2; ++bj)
#pragma unroll
                        for (int n = 0; n < 2; ++n) xr[(st + 1) & 1][bj][n] = *(const f32x4*)(xres + (size_t)nrow * 1024 + colb + bj * 128 + n * 16); }
                asm volatile("" ::: "memory");
#pragma unroll
                for (int bj = 0; bj < 2; ++bj)
#pragma unroll
                    for (int n = 0; n < 2; ++n) acc[ai][bj][m][n] = ALPHA * xr[st & 1][bj][n] + gm[bj][n] * acc[ai][bj][m][n];
                asm volatile("" : "+v"(acc[ai][0][m][0]), "+v"(acc[ai][0][m][1]), "+v"(acc[ai][1][m][0]), "+v"(acc[ai][1][m][1])); }
        } else if constexpr (XIN == 2) {
            const int colb = u.pn * 256 + wc * 32 + 4 * fq, rowb = u.pm * 256 + wr * 64 + fr;
            f32x4 gm[2][2]; u32x2 xr[2][2][2];
#pragma unroll
            for (int bj = 0; bj < 2; ++bj)
#pragma unroll
                for (int n = 0; n < 2; ++n) { gm[bj][n] = *(const f32x4*)(mods + (size_t)ns * NMOD + gate_off + colb + bj * 128 + n * 16); xr[0][bj][n] = *(const u32x2*)(xbi + (size_t)rowb * 1024 + colb + bj * 128 + n * 16); }
#pragma unroll
            for (int st = 0; st < 8; ++st) { const int ai = st >> 2, m = st & 3;
                if (st + 1 < 8) { const int nrow = rowb + ((st + 1) >> 2) * 128 + ((st + 1) & 3) * 16;
#pragma unroll
                    for (int bj = 0; bj < 2; ++bj)
#pragma unroll
                        for (int n = 0; n < 2; ++n) xr[(st + 1) & 1][bj][n] = *(const u32x2*)(xbi + (size_t)nrow * 1024 + colb + bj * 128 + n * 16); }
                asm volatile("" ::: "memory");
#pragma unroll
                for (int bj = 0; bj < 2; ++bj)
#pragma unroll
                    for (int n = 0; n < 2; ++n) { const u32x2 w = xr[st & 1][bj][n]; acc[ai][bj][m][n] = ALPHA * (f32x4){bflo(w.x), bfhi(w.x), bflo(w.y), bfhi(w.y)} + gm[bj][n] * acc[ai][bj][m][n]; }
                asm volatile("" : "+v"(acc[ai][0][m][0]), "+v"(acc[ai][0][m][1]), "+v"(acc[ai][1][m][0]), "+v"(acc[ai][1][m][1])); }
        } else {
            const int colb = u.pn * 256 + wc * 32 + 4 * fq, rowb = u.pm * 256 + wr * 64 + fr;
            f32x4 gm[2][2], g0[2][2], b0[2][2]; u32x2 tb[2][2][2]; f32x2v sr[2];
#pragma unroll
            for (int bj = 0; bj < 2; ++bj)
#pragma unroll
                for (int n = 0; n < 2; ++n) { const int col = colb + bj * 128 + n * 16; gm[bj][n] = *(const f32x4*)(mods + (size_t)ns * NMOD + gate_off + col);
                    g0[bj][n] = *(const f32x4*)(lg0 + col); b0[bj][n] = *(const f32x4*)(lb0 + col); tb[0][bj][n] = *(const u32x2*)(Tb + (size_t)rowb * 1024 + col); }
            sr[0] = *(const f32x2v*)(stats + (size_t)rowb * 2);
#pragma unroll
            for (int st = 0; st < 8; ++st) { const int ai = st >> 2, m = st & 3;
                if (st + 1 < 8) { const int nrow = rowb + ((st + 1) >> 2) * 128 + ((st + 1) & 3) * 16; sr[(st + 1) & 1] = *(const f32x2v*)(stats + (size_t)nrow * 2);
#pragma unroll
                    for (int bj = 0; bj < 2; ++bj)
#pragma unroll
                        for (int n = 0; n < 2; ++n) tb[(st + 1) & 1][bj][n] = *(const u32x2*)(Tb + (size_t)nrow * 1024 + colb + bj * 128 + n * 16); }
                asm volatile("" ::: "memory");
                const float mean = sr[st & 1].x, rstd = sr[st & 1].y;
#pragma unroll
                for (int bj = 0; bj < 2; ++bj)
#pragma unroll
                    for (int n = 0; n < 2; ++n) { const u32x2 w = tb[st & 1][bj][n]; const f32x4 t = (f32x4){bflo(w.x), bfhi(w.x), bflo(w.y), bfhi(w.y)};
                        const f32x4 x = (t - mean) * rstd * g0[bj][n] + b0[bj][n];
                        acc[ai][bj][m][n] = ALPHA * x + gm[bj][n] * acc[ai][bj][m][n]; }
                asm volatile("" : "+v"(acc[ai][0][m][0]), "+v"(acc[ai][0][m][1]), "+v"(acc[ai][1][m][0]), "+v"(acc[ai][1][m][1])); }
        }
#pragma unroll
        for (int ai = 0; ai < 2; ++ai)
#pragma unroll
            for (int m = 0; m < 4; ++m) { float s_ = 0.f, q_ = 0.f;
#pragma unroll
                for (int bj = 0; bj < 2; ++bj)
#pragma unroll
                    for (int n = 0; n < 2; ++n) { const f32x4 x = acc[ai][bj][m][n]; s_ += (x[0] + x[1]) + (x[2] + x[3]); q_ += (x[0] * x[0] + x[1] * x[1]) + (x[2] * x[2] + x[3] * x[3]); }
                s_ += __shfl_xor(s_, 16); s_ += __shfl_xor(s_, 32); q_ += __shfl_xor(q_, 16); q_ += __shfl_xor(q_, 32);
                if (fq == 0) Pt[(ai * 128 + wr * 64 + m * 16 + fr) * 4 + wc] = (f32x2v){s_, q_}; }
        __syncthreads();
        if (tid < 256) { const f32x2v a = Pt[tid * 4 + 0], b = Pt[tid * 4 + 1], c = Pt[tid * 4 + 2], d = Pt[tid * 4 + 3];
            const float S = (a.x + b.x) + (c.x + d.x), Q = (a.y + b.y) + (c.y + d.y);
            __hip_atomic_store(xbuf + ((size_t)(u.pm * 256 + tid) * 4 + u.pn), ((unsigned long long)__float_as_uint(Q) << 32) | __float_as_uint(S), __ATOMIC_RELAXED, __HIP_MEMORY_SCOPE_AGENT); }
        asm volatile("s_waitcnt vmcnt(0)" ::: "memory");
        if (tid < 256 && lane == 0) __hip_atomic_fetch_add(cnt + 16 * u.pm, 1u, __ATOMIC_RELAXED, __HIP_MEMORY_SCOPE_AGENT);
        if (wid == 0) { unsigned spins = 0;
            while ((unsigned)__builtin_amdgcn_readfirstlane(__hip_atomic_load(cnt + 16 * u.pm, __ATOMIC_RELAXED, __HIP_MEMORY_SCOPE_AGENT)) < 16u) { __builtin_amdgcn_s_sleep(1); if (++spins > (1u << 22)) break; }
            __builtin_amdgcn_fence(__ATOMIC_ACQUIRE, "agent"); asm volatile("s_waitcnt vmcnt(0)" ::: "memory"); }
        __syncthreads();
        if (tid < 256) { const unsigned long long* sl = xbuf + (size_t)(u.pm * 256 + tid) * 4; float S = 0.f, Q = 0.f;
#pragma unroll
            for (int t = 0; t < 4; ++t) { const unsigned long long w = __hip_atomic_load(sl + t, __ATOMIC_RELAXED, __HIP_MEMORY_SCOPE_AGENT); S += __uint_as_float((unsigned)w); Q += __uint_as_float((unsigned)(w >> 32)); }
            const float mean = S * (1.0f / 1024.0f), var = fmaxf(Q * (1.0f / 1024.0f) - mean * mean, 0.f);
            St[tid] = (f32x2v){mean, 1.0f / sqrtf(var + LN_EPS)}; }
        __syncthreads();
#pragma unroll
        for (int bj = 0; bj < 2; ++bj)
#pragma unroll
            for (int n = 0; n < 2; ++n) { const int col = u.pn * 256 + bj * 128 + wc * 32 + n * 16 + 4 * fq;
                const f32x4 gg = *(const f32x4*)(lg + col), bb = *(const f32x4*)(lb + col);
                f32x4 sh = (f32x4){0.f, 0.f, 0.f, 0.f}, sc = sh;
                if (next_off >= 0) { sh = *(const f32x4*)(mods + (size_t)ns * NMOD + next_off + col); sc = *(const f32x4*)(mods + (size_t)ns * NMOD + next_off + 1024 + col); }
#pragma unroll
                for (int ai = 0; ai < 2; ++ai)
#pragma unroll
                    for (int m = 0; m < 4; ++m) { const int rl = ai * 128 + wr * 64 + m * 16 + fr; const f32x2v st = St[rl]; const size_t off = (size_t)(u.pm * 256 + rl) * 1024 + col;
                        const f32x4 xn = (acc[ai][bj][m][n] - st.x) * st.y * gg + bb;
                        if constexpr (XOUT_F32) *(f32x4*)(xout + off) = xn; else { u32x2 xw; xw.x = cvt_pk_bf16(xn[0], xn[1]); xw.y = cvt_pk_bf16(xn[2], xn[3]); *(u32x2*)(xbo + off) = xw; }
                        if (next_off >= 0) { u32x2 w; w.x = cvt_pk_bf16(xn[0] * (1.f + sc[0]) + sh[0], xn[1] * (1.f + sc[1]) + sh[1]); w.y = cvt_pk_bf16(xn[2] * (1.f + sc[2]) + sh[2], xn[3] * (1.f + sc[3]) + sh[3]);
                            *(u32x2*)(hA + off) = w; } }
                asm volatile("" ::: "memory"); }
    }
};

template <int STEPS>
__device__ __forceinline__ void skinny_gemm(const bf16_t* A, int K, int nrb, int rows_valid, const bf16_t* Bt, int N, float* out, const float* bias, int ustart, int ustride) {
    const int tid = ltid(), wid = tid >> 6, lane = tid & 63, fr = lane & 15, fq = lane >> 4;
    const int KS = K / (32 * STEPS), ncb = N / 16, nunits = ncb * KS;
    for (int skr_ = 0; skr_ < SKREP; ++skr_)
    for (int u = ustart; u < nunits; u += ustride) {
        const int cb = u % ncb, ks = u / ncb, col0 = cb * 16, k0 = ks * 32 * STEPS;
        for (int rb = wid; rb < nrb; rb += 8) {
            const bf16_t* ap = A + (size_t)(rb * 16 + fr) * K + k0 + fq * 8; const bf16_t* bp = Bt + (size_t)(col0 + fr) * K + k0 + fq * 8;
            bf16x8 a[STEPS], b[STEPS];
#pragma unroll
            for (int i = 0; i < STEPS; ++i) { a[i] = *(const bf16x8*)(ap + 32 * i); b[i] = *(const bf16x8*)(bp + 32 * i); }
            f32x4 acc = (f32x4){0.f, 0.f, 0.f, 0.f};
#pragma unroll
            for (int i = 0; i < STEPS; ++i) acc = __builtin_amdgcn_mfma_f32_16x16x32_bf16(b[i], a[i], acc, 0, 0, 0);
            const int row = rb * 16 + fr;
            if (row < rows_valid) { const int c = col0 + fq * 4; if (bias) acc += *(const f32x4*)(bias + c);
                *(f32x4*)(out + ((size_t)ks * rows_valid + row) * N + c) = acc; }
        }
    }
}
__device__ __forceinline__ f32x4 rawsum4(const float* raw, size_t idx, int KS, size_t stride) { f32x4 v = *(const f32x4*)(raw + idx); for (int k = 1; k < KS; ++k) v += *(const f32x4*)(raw + k * stride + idx); return v; }
__device__ __forceinline__ float rawsum1(const float* raw, size_t idx, int KS, size_t stride) { float v = raw[idx]; for (int k = 1; k < KS; ++k) v += raw[k * stride + idx]; return v; }
__device__ __forceinline__ void skinny3(LAS float* sm, const bf16_t* A, int K, const bf16_t* Bt, int N, float* out, int ustart, int ustride) {
    const int tid = ltid(), wid = __builtin_amdgcn_readfirstlane(tid >> 6), lane = tid & 63, fr = lane & 15, fq = lane >> 4;
    const int nsteps = K / 256, ncb = N / 16;
    const unsigned loff = (unsigned)(fr * K + fq * 8);
    for (int skr_ = 0; skr_ < SKREP; ++skr_)
    for (int u = ustart; u < ncb; u += ustride) {
        const int col0 = u * 16;
        f32x4 acc[8];
#pragma unroll
        for (int rb = 0; rb < 8; ++rb) acc[rb] = (f32x4){0.f, 0.f, 0.f, 0.f};
        for (int s0 = 0; s0 < nsteps; s0 += 4) {
            const int cnt = nsteps - s0; const size_t ku = (size_t)(wid * nsteps + s0) * 32;
            const bf16_t* bu = Bt + (size_t)col0 * K + ku; const bf16_t* au = A + ku;
            bf16x8 b[4], a[8][4];
#pragma unroll
            for (int i = 0; i < 4; ++i) { const int ii = (i < cnt) ? i : 0; b[i] = *(const bf16x8*)(bu + 32 * ii + loff); }
#pragma unroll
            for (int rb = 0; rb < 8; ++rb)
#pragma unroll
                for (int i = 0; i < 4; ++i) { const int ii = (i < cnt) ? i : 0; a[rb][i] = *(const bf16x8*)(au + (size_t)rb * 16 * K + 32 * ii + loff); }
#pragma unroll
            for (int i = 0; i < 4; ++i) if (i >= cnt) b[i] = (bf16x8){0, 0, 0, 0, 0, 0, 0, 0};
#pragma unroll
            for (int rb = 0; rb < 8; ++rb)
#pragma unroll
                for (int i = 0; i < 4; ++i) acc[rb] = __builtin_amdgcn_mfma_f32_16x16x32_bf16(b[i], a[rb][i], acc[rb], 0, 0, 0);
        }
        __syncthreads();
#pragma unroll
        for (int rb = 0; rb < 8; ++rb) *(LAS f32x4*)(sm + ((wid * 8 + rb) * 16 + fr) * 16 + fq * 4) = acc[rb];
        __syncthreads();
        { const int row = tid >> 2, cq = tid & 3; f32x4 sum = (f32x4){0.f, 0.f, 0.f, 0.f};
#pragma unroll
            for (int w = 0; w < 8; ++w) sum += *(const LAS f32x4*)(sm + ((w * 8 + (row >> 4)) * 16 + (row & 15)) * 16 + cq * 4);
            *(f32x4*)(out + (size_t)row * N + col0 + cq * 4) = sum; }
    }
}
__device__ __forceinline__ void skinny_up(KP& P, int layer, LAS float* sm, const bf16_t* A, const bf16_t* Bt, int ustart, int ustride) {
    const int tid = ltid(), wid = __builtin_amdgcn_readfirstlane(tid >> 6), lane = tid & 63, fr = lane & 15, fq = lane >> 4;
    constexpr int K = 1024; const unsigned loff = (unsigned)(fr * K + fq * 8);
    const float* cw = P.ffn_conv_w + (size_t)layer * 3 * DFF2; const float* cb = P.ffn_conv_b + (size_t)layer * DFF2; bf16_t* act = (bf16_t*)(P.ws + WS_BIG);
    for (int u = ustart; u < DFF / 16; u += ustride) {
        const int c0 = u * 16, rv = pcol(c0); const size_t ku = (size_t)wid * 128;
        bf16x8 a[8][4], b[4]; f32x4 accv[8], accg[8];
#pragma unroll
        for (int rb = 0; rb < 8; ++rb)
#pragma unroll
            for (int i = 0; i < 4; ++i) a[rb][i] = *(const bf16x8*)(A + ku + (size_t)rb * 16 * K + 32 * i + loff);
#pragma unroll
        for (int i = 0; i < 4; ++i) b[i] = *(const bf16x8*)(Bt + (size_t)rv * K + ku + 32 * i + loff);
#pragma unroll
        for (int rb = 0; rb < 8; ++rb) { accv[rb] = (f32x4){0.f, 0.f, 0.f, 0.f};
#pragma unroll
            for (int i = 0; i < 4; ++i) accv[rb] = __builtin_amdgcn_mfma_f32_16x16x32_bf16(b[i], a[rb][i], accv[rb], 0, 0, 0); }
#pragma unroll
        for (int i = 0; i < 4; ++i) b[i] = *(const bf16x8*)(Bt + (size_t)(rv + 128) * K + ku + 32 * i + loff);
#pragma unroll
        for (int rb = 0; rb < 8; ++rb) { accg[rb] = (f32x4){0.f, 0.f, 0.f, 0.f};
#pragma unroll
            for (int i = 0; i < 4; ++i) accg[rb] = __builtin_amdgcn_mfma_f32_16x16x32_bf16(b[i], a[rb][i], accg[rb], 0, 0, 0); }
        __syncthreads();
#pragma unroll
        for (int rb = 0; rb < 8; ++rb) { *(LAS f32x4*)(sm + ((wid * 8 + rb) * 16 + fr) * 16 + fq * 4) = accv[rb]; *(LAS f32x4*)(sm + 16384 + ((wid * 8 + rb) * 16 + fr) * 16 + fq * 4) = accg[rb]; }
        __syncthreads();
        { const int row = tid >> 2, cq = tid & 3, c = c0 + cq * 4; f32x4 uv = (f32x4){0.f, 0.f, 0.f, 0.f}, ug = uv;
#pragma unroll
            for (int w = 0; w < 8; ++w) { uv += *(const LAS f32x4*)(sm + ((w * 8 + (row >> 4)) * 16 + (row & 15)) * 16 + cq * 4); ug += *(const LAS f32x4*)(sm + 16384 + ((w * 8 + (row >> 4)) * 16 + (row & 15)) * 16 + cq * 4); }
            const float* st = P.st_ffn + (size_t)(layer * NS + row) * 2 * DFF2; float* so = P.out + O_FFN_S + (size_t)(layer * NS + row) * 2 * DFF2;
            const f32x4 b0v = *(const f32x4*)(st + c), b1v = *(const f32x4*)(st + DFF2 + c), b0g = *(const f32x4*)(st + DFF + c), b1g = *(const f32x4*)(st + DFF2 + DFF + c);
            const f32x4 cv = *(const f32x4*)(cw + 2 * DFF2 + c) * uv + *(const f32x4*)(cw + DFF2 + c) * b1v + *(const f32x4*)(cw + c) * b0v + *(const f32x4*)(cb + c);
            const f32x4 cg_ = *(const f32x4*)(cw + 2 * DFF2 + DFF + c) * ug + *(const f32x4*)(cw + DFF2 + DFF + c) * b1g + *(const f32x4*)(cw + DFF + c) * b0g + *(const f32x4*)(cb + DFF + c);
            *(f32x4*)(so + c) = b1v; *(f32x4*)(so + DFF2 + c) = uv; *(f32x4*)(so + DFF + c) = b1g; *(f32x4*)(so + DFF2 + DFF + c) = ug;
            u32x2 w; w.x = cvt_pk_bf16(gelu_tanh(cg_[0]) * cv[0], gelu_tanh(cg_[1]) * cv[1]); w.y = cvt_pk_bf16(gelu_tanh(cg_[2]) * cv[2], gelu_tanh(cg_[3]) * cv[3]);
            *(u32x2*)(act + (size_t)(MP + row) * DFF + c) = w; }
    }
    __syncthreads();
}

struct TrD { const float* W; bf16_t* Bt; int K, Nsrc, mode, half, rb, kb; };
__device__ __forceinline__ bool tr_decode(KP& P, int it, TrD& d) {
    if (it < 0 || it >= 1504) return false;
    unsigned char* ws = P.ws; int i = it;
    if (i < 64) { d = TrD{P.s5_w_in, (bf16_t*)(ws + WS_WIN), 1024, 1024, 0, 0, i / 16, i % 16}; return true; } i -= 64;
    if (i < 128) { d = TrD{P.w_glu, (bf16_t*)(ws + WS_WGLU), 1024, 2048, 1, 1024, i / 16, i % 16}; return true; } i -= 128;
    if (i < 192) { d = TrD{P.sc_w_in, (bf16_t*)(ws + WS_SCIN), 1024, 3072, 2, 0, i / 16, i % 16}; return true; } i -= 192;
    if (i < 64) { d = TrD{P.sc_w_out, (bf16_t*)(ws + WS_SCOUT), 1024, 1024, 0, 0, i / 16, i % 16}; return true; } i -= 64;
    if (i < 704) { const int l = i / 352, j = i % 352; d = TrD{P.ffn_w_up + (size_t)l * 1024 * DFF2, (bf16_t*)(ws + WS_UP) + (size_t)l * DFF2 * 1024, 1024, DFF2, 1, DFF, j / 16, j % 16}; return true; } i -= 704;
    { const int l = i / 176, j = i % 176; d = TrD{P.ffn_w_down + (size_t)l * DFF * 1024, (bf16_t*)(ws + WS_DOWN) + (size_t)l * 1024 * DFF, DFF, 1024, 0, 0, j / 44, j % 44}; return true; }
}
__device__ __forceinline__ void tr_load(const TrD& d, int tid, f32x4 (&r)[8]) {
#pragma unroll
    for (int i = 0; i < 8; ++i) { const int idx4 = tid + NTHR * i, kr = idx4 >> 6, nc4 = (idx4 & 63) * 4, sb = nc4 >> 6, within = sb * 64;
        int src0;
        if (d.mode == 0) src0 = d.rb * 256 + within;
        else if (d.mode == 1) src0 = (within < 128) ? 128 * d.rb + within : d.half + 128 * d.rb + within - 128;
        else { if (d.rb < 4) src0 = d.rb * 256 + within; else { const int t = d.rb - 4; src0 = (within < 128) ? 1024 + 128 * t + within : 2048 + 128 * t + within - 128; } }
        r[i] = *(const f32x4*)(d.W + (size_t)(d.kb * 64 + kr) * d.Nsrc + src0 + (nc4 & 63)); }
}
__device__ __forceinline__ void tr_store(LAS float* sm, const TrD& d, int tid, const f32x4 (&r)[8]) {
    __syncthreads();
#pragma unroll
    for (int i = 0; i < 8; ++i) { const int idx4 = tid + NTHR * i, kr = idx4 >> 6, nc4 = (idx4 & 63) * 4; LAS float* q = sm + kr * 257 + nc4; q[0] = r[i][0]; q[1] = r[i][1]; q[2] = r[i][2]; q[3] = r[i][3]; }
    __syncthreads();
#pragma unroll
    for (int i = 0; i < 4; ++i) { const int np = (tid >> 3) + 64 * i, kp = tid & 7; float e[8];
#pragma unroll
        for (int q = 0; q < 8; ++q) e[q] = sm[(kp * 8 + q) * 257 + np];
        u32x4 w; w.x = cvt_pk_bf16(e[0], e[1]); w.y = cvt_pk_bf16(e[2], e[3]); w.z = cvt_pk_bf16(e[4], e[5]); w.w = cvt_pk_bf16(e[6], e[7]);
        *(u32x4*)(d.Bt + (size_t)(d.rb * 256 + np) * d.K + d.kb * 64 + kp * 8) = w; }
}
__device__ __forceinline__ int p0_item(int bx, int G, int k) {
    if (G != 256) return bx + G * k;
    return bx < 64 ? (k < 7 ? bx + 64 * k : -1) : 448 + (bx - 64) + 192 * k;
}
__device__ __forceinline__ void p0_convert(KP& P, LAS float* sm) {
    unsigned char* ws = P.ws; const int G = gridDim.x, bx = blockIdx.x, tid = ltid();
    int k = 0; TrD d, dn; f32x4 r[8], rn[8];
    bool v = tr_decode(P, p0_item(bx, G, 0), d);
    if (v) tr_load(d, tid, r);
    while (v) {
        ++k; const bool vn = tr_decode(P, p0_item(bx, G, k), dn);
        if (vn) tr_load(dn, tid, rn);
        tr_store(sm, d, tid, r);
        d = dn; v = vn;
#pragma unroll
        for (int i = 0; i < 8; ++i) r[i] = rn[i];
    }
}
__device__ __forceinline__ void mods_phase(KP& P, LAS float* sm, int ustart, int ustride) {
    const int tid = ltid(), wid = __builtin_amdgcn_readfirstlane(tid >> 6), lane = tid & 63, fr = lane & 15, fq = lane >> 4;
    float* mods = (float*)(P.ws + WS_MODS);
    const int ct = wid & 3, rb0 = wid >> 2; constexpr int PITCH = 65, BUF = 128 * PITCH, APITCH = 136;
    LAS bf16_t* sA = (LAS bf16_t*)(sm + 2 * BUF);
    auto ldc = [&](int ch, f32x4 (&cv)[9]) {
#pragma unroll
        for (int i = 0; i < 9; ++i) { const int e = tid + NTHR * i, row = e >> 5, k = ch * 128 + (e & 31) * 4;
            cv[i] = (f32x4){0.f, 0.f, 0.f, 0.f};
            if (row < 8) cv[i] = *(const f32x4*)(P.c_p + (size_t)row * 1024 + k); else if (row < 136) cv[i] = *(const f32x4*)(P.c_s + (size_t)(row - 8) * 1024 + k); } };
    for (int u = ustart; u < NMOD / 64; u += ustride) {
        const int j0 = u * 64; f32x4 acc[5], r[4], rn[4], cv[9], cn[9];
#pragma unroll
        for (int i = 0; i < 5; ++i) acc[i] = (f32x4){0.f, 0.f, 0.f, 0.f};
#pragma unroll
        for (int i = 0; i < 4; ++i) { const int idx = tid + NTHR * i, kr = idx >> 4, c4 = (idx & 15) * 4; r[i] = *(const f32x4*)(P.w_ada + (size_t)kr * NMOD + j0 + c4); }
        ldc(0, cv);
        for (int ch = 0; ch < 8; ++ch) {
            if (ch + 1 < 8) {
#pragma unroll
                for (int i = 0; i < 4; ++i) { const int idx = tid + NTHR * i, kr = idx >> 4, c4 = (idx & 15) * 4; rn[i] = *(const f32x4*)(P.w_ada + (size_t)((ch + 1) * 128 + kr) * NMOD + j0 + c4); }
                ldc(ch + 1, cn);
            }
            __syncthreads();
            LAS float* buf = sm + (ch & 1) * BUF;
#pragma unroll
            for (int i = 0; i < 4; ++i) { const int idx = tid + NTHR * i, kr = idx >> 4, c4 = (idx & 15) * 4; LAS float* q = buf + kr * PITCH + c4; q[0] = r[i][0]; q[1] = r[i][1]; q[2] = r[i][2]; q[3] = r[i][3]; }
#pragma unroll
            for (int i = 0; i < 9; ++i) { const int e = tid + NTHR * i, row = e >> 5, k4 = (e & 31) * 4; const f32x4 c = cv[i]; u32x2 w;
                w.x = cvt_pk_bf16(c[0] * sigmoidf_(c[0]), c[1] * sigmoidf_(c[1])); w.y = cvt_pk_bf16(c[2] * sigmoidf_(c[2]), c[3] * sigmoidf_(c[3]));
                *(LAS u32x2*)(sA + row * APITCH + k4) = w; }
            __syncthreads();
#pragma unroll
            for (int s_ = 0; s_ < 4; ++s_) { float w[8]; bf16x8 a[5];
#pragma unroll
                for (int i = 0; i < 5; ++i) { const int rb = (rb0 + 2 * i < 9) ? rb0 + 2 * i : rb0; a[i] = *(const LAS bf16x8*)(sA + (rb * 16 + fr) * APITCH + s_ * 32 + fq * 8); }
#pragma unroll
                for (int e = 0; e < 8; ++e) w[e] = buf[(s_ * 32 + fq * 8 + e) * PITCH + ct * 16 + fr];
                u32x4 pk; pk.x = cvt_pk_bf16(w[0], w[1]); pk.y = cvt_pk_bf16(w[2], w[3]); pk.z = cvt_pk_bf16(w[4], w[5]); pk.w = cvt_pk_bf16(w[6], w[7]);
                const bf16x8 bfr = __builtin_bit_cast(bf16x8, pk);
#pragma unroll
                for (int i = 0; i < 5; ++i) acc[i] = __builtin_amdgcn_mfma_f32_16x16x32_bf16(bfr, a[i], acc[i], 0, 0, 0); }
#pragma unroll
            for (int i = 0; i < 4; ++i) r[i] = rn[i];
#pragma unroll
            for (int i = 0; i < 9; ++i) cv[i] = cn[i];
        }
        const int col = j0 + ct * 16 + fq * 4; const f32x4 bias = *(const f32x4*)(P.b_ada + col);
#pragma unroll
        for (int i = 0; i < 5; ++i) { const int rb = rb0 + 2 * i, row = rb * 16 + fr; if (rb < 9 && row < 136) *(f32x4*)(mods + (size_t)row * NMOD + col) = acc[i] + bias; }
    }
    __syncthreads();
}
__device__ __forceinline__ void p0_s5_tables(KP& P, LAS float* sm) {
    LAS float* apr = sm; LAS float* api = apr + 17 * 64; LAS float* Br = api + 17 * 64; LAS float* Bi = Br + 1024; LAS float* Cr = Bi + 1024; LAS float* Ci = Cr + 1024; LAS float* Kt = Ci + 1024;
    const int tid = ltid(), G = gridDim.x;
    bf16_t* T1 = (bf16_t*)(P.ws + WS_BIG + BIG_TAB1); bf16_t* T2 = (bf16_t*)(P.ws + WS_BIG + BIG_TAB2);
    for (int g = (int)blockIdx.x; g < 64; g += G) {
        __syncthreads();
        for (int t = tid; t < 17 * 64; t += NTHR) { const int p = t & 63, e = t >> 6; double ar, ai; apow_d(P, g, p, (double)e, ar, ai); apr[e * 64 + p] = (float)ar; api[e * 64 + p] = (float)ai; }
        for (int t = tid; t < 1024; t += NTHR) { const int p = t >> 4, c = t & 15; double cr, ci; bcoef_d(P, g, p, cr, ci);
            const double br = (double)P.b_re[(g * 64 + p) * 16 + c], bi = (double)P.b_im[(g * 64 + p) * 16 + c];
            const float fr_ = (float)(cr * br - ci * bi), fi_ = (float)(cr * bi + ci * br);
            Br[p * 16 + c] = fr_; Bi[p * 16 + c] = fi_;
            float* bb = (float*)(P.ws + WS_BBAR) + ((size_t)(g * 64 + p) * 16 + c) * 2; bb[0] = fr_; bb[1] = fi_; }
        if (tid < 64) { float* sc = (float*)(P.ws + WS_S5C) + (size_t)(g * 64 + tid) * 8; double ar, ai;
            apow_d(P, g, tid, 1.0, ar, ai); sc[0] = (float)ar; sc[1] = (float)ai;
            apow_d(P, g, tid, 16.0, ar, ai); sc[2] = (float)ar; sc[3] = (float)ai;
            apow_d(P, g, tid, 512.0, ar, ai); sc[4] = (float)ar; sc[5] = (float)ai; sc[6] = 0.f; sc[7] = 0.f; }
        for (int t = tid; t < 1024; t += NTHR) { Cr[t] = P.c_re[g * 1024 + t]; Ci[t] = P.c_im[g * 1024 + t]; }
        __syncthreads();
        for (int idx = tid; idx < 4096; idx += NTHR) { const int e = idx >> 8, c = (idx >> 4) & 15, cp = idx & 15; float s = 0.f;
            for (int p = 0; p < 64; ++p) { const float ar = apr[e * 64 + p], ai = api[e * 64 + p], br = Br[p * 16 + cp], bi = Bi[p * 16 + cp];
                const float xr = ar * br - ai * bi, xi = ar * bi + ai * br; s += Cr[c * 64 + p] * xr - Ci[c * 64 + p] * xi; }
            Kt[idx] = s; }
        __syncthreads();
        for (int it = tid; it < 256 * 48; it += NTHR) { const int row = it / 48, kg = it % 48, l = row >> 4, c = row & 15; float v[8];
            if (kg < 32) { const int j = kg >> 1, c0 = (kg & 1) * 8;
#pragma unroll
                for (int i = 0; i < 8; ++i) v[i] = (j <= l) ? Kt[(l - j) * 256 + c * 16 + c0 + i] : 0.f;
            } else { const int q0 = (kg - 32) * 8;
#pragma unroll
                for (int i = 0; i < 8; ++i) { const int q = q0 + i, p = q & 63; const float cr = Cr[c * 64 + p], ci = Ci[c * 64 + p], ar = apr[(l + 1) * 64 + p], ai = api[(l + 1) * 64 + p];
                    v[i] = (q < 64) ? (cr * ar - ci * ai) : -(cr * ai + ci * ar); } }
            u32x4 w; w.x = cvt_pk_bf16(v[0], v[1]); w.y = cvt_pk_bf16(v[2], v[3]); w.z = cvt_pk_bf16(v[4], v[5]); w.w = cvt_pk_bf16(v[6], v[7]);
            *(u32x4*)(T2 + ((size_t)g * 256 + row) * 384 + kg * 8) = w; }
        for (int it = tid; it < 128 * 32; it += NTHR) { const int q = it >> 5, kg = it & 31, j = kg >> 1, c0 = (kg & 1) * 8, p = q & 63; float v[8];
            const float ar = apr[(15 - j) * 64 + p], ai = api[(15 - j) * 64 + p];
#pragma unroll
            for (int i = 0; i < 8; ++i) { const float br = Br[p * 16 + c0 + i], bi = Bi[p * 16 + c0 + i]; v[i] = (q < 64) ? (ar * br - ai * bi) : (ar * bi + ai * br); }
            u32x4 w; w.x = cvt_pk_bf16(v[0], v[1]); w.y = cvt_pk_bf16(v[2], v[3]); w.z = cvt_pk_bf16(v[4], v[5]); w.w = cvt_pk_bf16(v[6], v[7]);
            *(u32x4*)(T1 + ((size_t)g * 128 + q) * 256 + kg * 8) = w; }
    }
}

__device__ __forceinline__ void modulate_phase(KP& P) { const int tidl_ = ltid();
    const int wid = tidl_ >> 6, lane = tidl_ & 63; const float* mods = (const float*)(P.ws + WS_MODS); bf16_t* hA = (bf16_t*)(P.ws + WS_H);
    const int G_ = gridDim.x, nw = G_ * 8, per = nw >> 3;
    if ((G_ & 7) == 0) {
        const int vb = ((int)blockIdx.x % 8) * (G_ / 8) + (int)blockIdx.x / 8, w = vb * 8 + wid, bseq = w / per, r0 = w - bseq * per;
        const float* sh = mods + (size_t)bseq * NMOD; const float* sc = sh + 1024;
#pragma unroll 2
        for (int l = r0; l < SEQ; l += per) { const size_t row = (size_t)bseq * SEQ + l;
#pragma unroll
            for (int i = 0; i < 4; ++i) { const int c = i * 256 + lane * 4; const f32x4 x = *(const f32x4*)(P.x_p + row * 1024 + c), a = *(const f32x4*)(sc + c), b = *(const f32x4*)(sh + c);
                u32x2 wv; wv.x = cvt_pk_bf16(x[0] * (1.f + a[0]) + b[0], x[1] * (1.f + a[1]) + b[1]); wv.y = cvt_pk_bf16(x[2] * (1.f + a[2]) + b[2], x[3] * (1.f + a[3]) + b[3]);
                *(u32x2*)(hA + row * 1024 + c) = wv; } }
    }
    for (int row = ((G_ & 7) == 0 ? MP : 0) + blockIdx.x * 8 + wid; row < MT; row += G_ * 8) {
        const int ns = row < MP ? (row >> 11) : 8 + (row - MP); const float* xr = row < MP ? P.x_p + (size_t)row * 1024 : P.x_s + (size_t)(row - MP) * 1024;
        const float* sh = mods + (size_t)ns * NMOD; const float* sc = sh + 1024;
#pragma unroll
        for (int i = 0; i < 4; ++i) { const int c = i * 256 + lane * 4; const f32x4 x = *(const f32x4*)(xr + c), a = *(const f32x4*)(sc + c), b = *(const f32x4*)(sh + c);
            u32x2 w; w.x = cvt_pk_bf16(x[0] * (1.f + a[0]) + b[0], x[1] * (1.f + a[1]) + b[1]); w.y = cvt_pk_bf16(x[2] * (1.f + a[2]) + b[2], x[3] * (1.f + a[3]) + b[3]);
            *(u32x2*)(hA + (size_t)row * 1024 + c) = w; }
    }
}
__device__ __forceinline__ void ln_finish(int row, f32x4 (&v)[4], int lane, const f32x4 (&gg)[4], const f32x4 (&bb)[4], const f32x4 (&sh)[4], const f32x4 (&sc)[4], float* xout, bool has_next, bf16_t* hA, float* stats) {
    float s = 0.f;
#pragma unroll
    for (int i = 0; i < 4; ++i) s += (v[i][0] + v[i][1]) + (v[i][2] + v[i][3]);
    const float mean = wave_sum(s) * (1.0f / 1024.0f); float q = 0.f;
#pragma unroll
    for (int i = 0; i < 4; ++i) { const f32x4 d = v[i] - mean; q += (d[0] * d[0] + d[1] * d[1]) + (d[2] * d[2] + d[3] * d[3]); }
    const float rstd = 1.0f / sqrtf(wave_sum(q) * (1.0f / 1024.0f) + LN_EPS);
    if (stats && lane == 0) { stats[(size_t)row * 2] = mean; stats[(size_t)row * 2 + 1] = rstd; }
#pragma unroll
    for (int i = 0; i < 4; ++i) { const int c = i * 256 + lane * 4;
        const f32x4 xn = (v[i] - mean) * rstd * gg[i] + bb[i];
        if (!stats) *(f32x4*)(xout + (size_t)row * 1024 + c) = xn;
        if (has_next) { u32x2 w; w.x = cvt_pk_bf16(xn[0] * (1.f + sc[i][0]) + sh[i][0], xn[1] * (1.f + sc[i][1]) + sh[i][1]); w.y = cvt_pk_bf16(xn[2] * (1.f + sc[i][2]) + sh[i][2], xn[3] * (1.f + sc[i][3]) + sh[i][3]);
            *(u32x2*)(hA + (size_t)row * 1024 + c) = w; } }
}
__device__ __forceinline__ void ln_phase(KP& P, int li, int lj, int smode, int KS, const float* xres_s, int next_off  , bool do_prompt) { const int tidl_ = ltid();
    const int wid = tidl_ >> 6, lane = tidl_ & 63; const float* mods = (const float*)(P.ws + WS_MODS); bf16_t* hA = (bf16_t*)(P.ws + WS_H);
    const bf16_t* T = (const bf16_t*)(P.ws + WS_T); const float* raw = (const float*)(P.ws + WS_RAW);
    const float* lg = P.ln_g + (li * 2 + lj) * 1024; const float* lb = P.ln_b + (li * 2 + lj) * 1024; const int gate_off = ((li * 2 + lj) * 3 + 2) * 1024;
    const int stride = gridDim.x * 8; const bool has_next = next_off >= 0;
    f32x4 gg[4], bb[4], sh[4], sc[4];
#pragma unroll
    for (int i = 0; i < 4; ++i) { const int c = i * 256 + lane * 4; gg[i] = *(const f32x4*)(lg + c); bb[i] = *(const f32x4*)(lb + c); sh[i] = (f32x4){0.f, 0.f, 0.f, 0.f}; sc[i] = sh[i]; }
    if (do_prompt) {
        const int G_ = gridDim.x, vb = (G_ % 8 == 0) ? ((int)blockIdx.x % 8) * (G_ / 8) + (int)blockIdx.x / 8 : (int)blockIdx.x;
        const int nw = stride, w = vb * 8 + wid, per = nw >> 3;
        if ((nw & 7) == 0 && per > 0) {
            const int bseq = w / per, r0 = w - bseq * per;
            if (has_next) {
#pragma unroll
                for (int i = 0; i < 4; ++i) { const int c = i * 256 + lane * 4; sh[i] = *(const f32x4*)(mods + (size_t)bseq * NMOD + next_off + c); sc[i] = *(const f32x4*)(mods + (size_t)bseq * NMOD + next_off + 1024 + c); }
            }
            int l = r0; f32x4 v[4], nx[4];
            if (l < SEQ) {
#pragma unroll
                for (int i = 0; i < 4; ++i) { const u32x2 w = *(const u32x2*)(T + (size_t)(bseq * SEQ + l) * 1024 + i * 256 + lane * 4); v[i] = (f32x4){bflo(w.x), bfhi(w.x), bflo(w.y), bfhi(w.y)}; }
            }
            for (; l < SEQ; l += per) { const int nl = l + per;
                if (nl < SEQ) {
#pragma unroll
                    for (int i = 0; i < 4; ++i) { const u32x2 w = *(const u32x2*)(T + (size_t)(bseq * SEQ + nl) * 1024 + i * 256 + lane * 4); nx[i] = (f32x4){bflo(w.x), bfhi(w.x), bflo(w.y), bfhi(w.y)}; }
                }
                ln_finish(bseq * SEQ + l, v, lane, gg, bb, sh, sc, P.out + O_Y, has_next, hA, (float*)(P.ws + WS_STATS));
#pragma unroll
                for (int i = 0; i < 4; ++i) v[i] = nx[i];
            }
        }
    }
    for (int n = (gridDim.x - 1 - blockIdx.x) * 8 + wid; n < NS; n += stride) {
        const int row = MP + n, ns = 8 + n; f32x4 v[4];
#pragma unroll
        for (int i = 0; i < 4; ++i) { const int c = i * 256 + lane * 4; f32x4 o;
            if (smode == 0) { const f32x4 a = rawsum4(raw, (size_t)n * 2048 + pcol(c), KS, (size_t)128 * 2048), gt = rawsum4(raw, (size_t)n * 2048 + pcol(c) + 128, KS, (size_t)128 * 2048);
#pragma unroll
                for (int j = 0; j < 4; ++j) o[j] = a[j] * sigmoidf_(gt[j]);
            } else o = rawsum4(raw, (size_t)n * 1024 + c, KS, (size_t)128 * 1024);
            const f32x4 xr = *(const f32x4*)(xres_s + (size_t)n * 1024 + c), gm = *(const f32x4*)(mods + (size_t)ns * NMOD + gate_off + c);
            v[i] = ALPHA * xr + gm * o;
            if (has_next) { sh[i] = *(const f32x4*)(mods + (size_t)ns * NMOD + next_off + c); sc[i] = *(const f32x4*)(mods + (size_t)ns * NMOD + next_off + 1024 + c); } }
        ln_finish(row, v, lane, gg, bb, sh, sc, P.out + O_Y, has_next, hA, nullptr);
    }
}

__device__ __forceinline__ void s5_prompt(KP& P, LAS unsigned char* lds) {
    bf16_t* A2 = (bf16_t*)(P.ws + WS_T); bf16_t* hA = (bf16_t*)(P.ws + WS_H);
    for (int idx = blockIdx.x; idx < 256; idx += gridDim.x) {
        const int g = idx >> 2, pm = idx & 3;
        bf16_t* A2g = A2 + (size_t)g * 1024 * 384;
        float* Slg = (float*)(P.ws + WS_BIG + BIG_SLOC) + (size_t)g * 1024 * 128;
        { Gemm gm{A2g, (const bf16_t*)(P.ws + WS_BIG + BIG_TAB1) + (size_t)g * 128 * 256, 384, 256, 256}; OneUnit S{{pm, 0}}; EpiS1 E{Slg}; gemm_phase(lds, gm, S, E); }
        asm volatile("s_waitcnt vmcnt(0)" ::: "memory"); __syncthreads();
        {
            const int tid = ltid();
            const int nl = tid >> 8, seg = (tid >> 6) & 3, p = tid & 63; const int rowbase = pm * 256 + nl * 128 + seg * 32;
            const float* sl = Slg + (size_t)rowbase * 128; float lre[32], lim[32];
#pragma unroll
            for (int k = 0; k < 32; ++k) { lre[k] = sl[k * 128 + p]; lim[k] = sl[k * 128 + 64 + p]; }
            const float* sc = (const float*)(P.ws + WS_S5C) + (size_t)(g * 64 + p) * 8;
            const float a16r = sc[2], a16i = sc[3], a512r = sc[4], a512i = sc[5];
            float sr = 0.f, si = 0.f;
#pragma unroll
            for (int k = 0; k < 32; ++k) { const float nr = a16r * sr - a16i * si + lre[k], ni = a16r * si + a16i * sr + lim[k]; sr = nr; si = ni; lre[k] = sr; lim[k] = si; }
            LAS float* Eb = (LAS float*)lds;
            Eb[((nl * 4 + seg) * 64 + p) * 2] = sr; Eb[((nl * 4 + seg) * 64 + p) * 2 + 1] = si;
            __syncthreads();
            float cr = 0.f, ci = 0.f;
            for (int s2 = 0; s2 < seg; ++s2) { const float er = Eb[((nl * 4 + s2) * 64 + p) * 2], ei = Eb[((nl * 4 + s2) * 64 + p) * 2 + 1];
                const float nr = a512r * cr - a512i * ci + er, ni = a512r * ci + a512i * cr + ei; cr = nr; ci = ni; }
            float pwr = 1.f, pwi = 0.f; bf16_t* dst = A2g + (size_t)rowbase * 384 + 256 + p;
#pragma unroll
            for (int k = 0; k < 32; ++k) { float vr, vi;
                if (k == 0) { vr = cr; vi = ci; } else { vr = lre[k - 1] + (pwr * cr - pwi * ci); vi = lim[k - 1] + (pwr * ci + pwi * cr); }
                const unsigned w = cvt_pk_bf16(vr, vi); dst[(size_t)k * 384] = (bf16_t)(w & 0xffffu); dst[(size_t)k * 384 + 64] = (bf16_t)(w >> 16);
                const float nr = pwr * a16r - pwi * a16i, ni = pwr * a16i + pwi * a16r; pwr = nr; pwi = ni; }
            if (seg == 3) { const int n = pm * 2 + nl;
                P.out[O_S5RE_P + (size_t)(n * 64 + g) * 64 + p] = lre[31] + (pwr * cr - pwi * ci);
                P.out[O_S5IM_P + (size_t)(n * 64 + g) * 64 + p] = lim[31] + (pwr * ci + pwi * cr); }
        }
        asm volatile("s_waitcnt vmcnt(0)" ::: "memory"); __syncthreads();
        { Gemm gm{A2g, (const bf16_t*)(P.ws + WS_BIG + BIG_TAB2) + (size_t)g * 256 * 384, 384, 384, 384}; OneUnit S{{pm, 0}}; EpiS2 E{A2g, P.s5_d, hA, g}; gemm_phase(lds, gm, S, E); }
        __syncthreads();
    }
}
__device__ __forceinline__ void s5_sample(KP& P) { const int tidl_ = ltid();
    const int wid = tidl_ >> 6, lane = tidl_ & 63; const float* raw = (const float*)(P.ws + WS_RAW); bf16_t* hA = (bf16_t*)(P.ws + WS_H);
    for (int wi = blockIdx.x * 8 + wid; wi < 2048; wi += gridDim.x * 8) {
        const int g = wi >> 5, n0 = (wi & 31) * 4, p = lane;
        const float* sc = (const float*)(P.ws + WS_S5C) + (size_t)(g * 64 + p) * 8; const float far = sc[0], fai = sc[1];
        const float* bbp = (const float*)(P.ws + WS_BBAR) + (size_t)(g * 64 + p) * 32;
        float Bre[16], Bim[16], Cre[16], Cim[16];
#pragma unroll
        for (int c = 0; c < 16; ++c) { Bre[c] = bbp[c * 2]; Bim[c] = bbp[c * 2 + 1];
            Cre[c] = P.c_re[(g * 16 + c) * 64 + p]; Cim[c] = P.c_im[(g * 16 + c) * 64 + p]; }
        const int cl = ((lane & 1) << 3) | ((lane & 2) << 1) | ((lane & 4) >> 1) | ((lane & 8) >> 3);
        const float dl = P.s5_d[g * 16 + cl];
        for (int nn = 0; nn < 4; ++nn) { const int n = n0 + nn;
            const float h0r = P.s5re[(size_t)(n * 64 + g) * 64 + p], h0i = P.s5im[(size_t)(n * 64 + g) * 64 + p];
            float sr = far * h0r - fai * h0i, si = far * h0i + fai * h0r;
#pragma unroll
            for (int c = 0; c < 16; ++c) { const float uc = raw[(size_t)n * 1024 + g * 16 + c]; sr += Bre[c] * uc; si += Bim[c] * uc; }
            P.out[O_S5RE_S + (size_t)(n * 64 + g) * 64 + p] = sr; P.out[O_S5IM_S + (size_t)(n * 64 + g) * 64 + p] = si;
            float v16[16];
#pragma unroll
            for (int c = 0; c < 16; ++c) v16[c] = Cre[c] * sr - Cim[c] * si;
            const bool b0 = lane & 1, b1 = lane & 2, b2 = lane & 4, b3 = lane & 8;
            float r8[8], s4[4], t2[2];
#pragma unroll
            for (int j = 0; j < 8; ++j) { const float mine = b0 ? v16[j + 8] : v16[j], send = b0 ? v16[j] : v16[j + 8]; r8[j] = mine + dppx<0xB1>(send); }
#pragma unroll
            for (int j = 0; j < 4; ++j) { const float mine = b1 ? r8[j + 4] : r8[j], send = b1 ? r8[j] : r8[j + 4]; s4[j] = mine + dppx<0x4E>(send); }
#pragma unroll
            for (int j = 0; j < 2; ++j) { const float mine = b2 ? s4[j + 2] : s4[j], send = b2 ? s4[j] : s4[j + 2]; t2[j] = mine + __shfl_xor(send, 4); }
            float ysel; { const float mine = b3 ? t2[1] : t2[0], send = b3 ? t2[0] : t2[1]; ysel = mine + dppx<0x128>(send); }
            ysel += __shfl_xor(ysel, 16); ysel += __shfl_xor(ysel, 32);
            if (lane < 16) { const float ul = raw[(size_t)n * 1024 + g * 16 + cl]; const float y = gelu_tanh(ysel + dl * ul);
                hA[(size_t)(MP + n) * 1024 + g * 16 + cl] = (bf16_t)(cvt_pk_bf16(y, 0.f) & 0xffffu); }
        }
    }
}

__device__ __forceinline__ void unpack8(const u32x4 w, float (&f)[8]) { f[0] = bflo(w.x); f[1] = bfhi(w.x); f[2] = bflo(w.y); f[3] = bfhi(w.y); f[4] = bflo(w.z); f[5] = bfhi(w.z); f[6] = bflo(w.w); f[7] = bfhi(w.w); }
__device__ __forceinline__ void ld8(const float* p, float (&f)[8]) { const f32x4 a = *(const f32x4*)p, b = *(const f32x4*)(p + 4); f[0] = a[0]; f[1] = a[1]; f[2] = a[2]; f[3] = a[3]; f[4] = b[0]; f[5] = b[1]; f[6] = b[2]; f[7] = b[3]; }
__device__ __forceinline__ void st8(float* p, const float (&f)[8]) { *(f32x4*)p = (f32x4){f[0], f[1], f[2], f[3]}; *(f32x4*)(p + 4) = (f32x4){f[4], f[5], f[6], f[7]}; }
__device__ __forceinline__ void ffn_fixup_rows(KP& P, int layer, int pm) { const int tidl_ = ltid();
    const bf16_t* halo = (const bf16_t*)(P.ws + WS_BIG + BIG_HALO); bf16_t* act = (bf16_t*)(P.ws + WS_BIG);
    const float* cw = P.ffn_conv_w + (size_t)layer * 3 * DFF2; const float* cb = P.ffn_conv_b + (size_t)layer * DFF2;
    constexpr int NOCT = DFF / 8;
    for (int id = tidl_; id < 4 * NOCT; id += NTHR) {
        float x0[2][8], x1[2][8], x2[2][8], w0[2][8], w1[2][8], w2[2][8], bb[2][8];
        const int loc = id / NOCT, oct = id - loc * NOCT, c0 = oct * 8;
        const int blk = pm * 2 + (loc >> 1), rr = loc & 1; const bool hp = (blk & 15) != 0; const size_t orow = (size_t)(blk * 128 + rr);
        const bf16_t* h0 = halo + (size_t)(blk * 4 + rr) * DFF2;
        const bf16_t* h1 = rr ? halo + (size_t)(blk * 4) * DFF2 : halo + (size_t)((blk - 1) * 4 + 3) * DFF2; const bool v1 = rr ? true : hp;
        const bf16_t* h2 = rr ? halo + (size_t)((blk - 1) * 4 + 3) * DFF2 : halo + (size_t)((blk - 1) * 4 + 2) * DFF2; const bool v2 = hp;
#pragma unroll
        for (int part = 0; part < 2; ++part) { const int col = part * DFF + c0;
            unpack8(*(const u32x4*)(h0 + col), x0[part]);
            if (v1) unpack8(*(const u32x4*)(h1 + col), x1[part]); else { for (int j = 0; j < 8; ++j) x1[part][j] = 0.f; }
            if (v2) unpack8(*(const u32x4*)(h2 + col), x2[part]); else { for (int j = 0; j < 8; ++j) x2[part][j] = 0.f; }
            ld8(cw + col, w0[part]); ld8(cw + DFF2 + col, w1[part]); ld8(cw + 2 * DFF2 + col, w2[part]); ld8(cb + col, bb[part]); }
        float o[8];
#pragma unroll
        for (int j = 0; j < 8; ++j) { const float cv = w2[0][j] * x0[0][j] + w1[0][j] * x1[0][j] + w0[0][j] * x2[0][j] + bb[0][j], cg_ = w2[1][j] * x0[1][j] + w1[1][j] * x1[1][j] + w0[1][j] * x2[1][j] + bb[1][j];
            o[j] = gelu_tanh(cg_) * cv; }
        u32x4 w; w.x = cvt_pk_bf16(o[0], o[1]); w.y = cvt_pk_bf16(o[2], o[3]); w.z = cvt_pk_bf16(o[4], o[5]); w.w = cvt_pk_bf16(o[6], o[7]);
        *(u32x4*)(act + orow * DFF + c0) = w;
    }
    asm volatile("s_waitcnt vmcnt(0)" ::: "memory"); __syncthreads();
}

__device__ __forceinline__ void shortconv_phase(KP& P) { const int tidl_ = ltid();
    const int G = gridDim.x; const bf16_t* z2 = (const bf16_t*)(P.ws + WS_BIG); bf16_t* hA = (bf16_t*)(P.ws + WS_H); const float* raw = (const float*)(P.ws + WS_RAW);
    const int c0 = (tidl_ & 127) * 8; float w0[8], w1[8], w2[8];
    ld8(P.sc_conv_w + c0, w0); ld8(P.sc_conv_w + 1024 + c0, w1); ld8(P.sc_conv_w + 2048 + c0, w2);
    const int vb_ = (G % 8 == 0) ? ((int)blockIdx.x % 8) * (G / 8) + (int)blockIdx.x / 8 : (int)blockIdx.x;
    const bool al_ = (G == 256); const int nk_ = al_ ? 16 : (MP + G * 4 - 1) / (G * 4);
#pragma unroll 4
    for (int k_ = 0; k_ < nk_; ++k_) { const int r = al_ ? (vb_ >> 5) * SEQ + (vb_ & 31) * 4 + (tidl_ >> 7) + 128 * k_ : (int)blockIdx.x * 4 + (tidl_ >> 7) + k_ * G * 4; if (r >= MP) break;
        const int l = r & 2047; float cur[8], m1[8], m2[8], gb[8], q[8];
        unpack8(*(const u32x4*)(z2 + (size_t)r * 2048 + 1024 + c0), cur); unpack8(*(const u32x4*)(z2 + (size_t)r * 2048 + c0), gb);
        if (l >= 1) unpack8(*(const u32x4*)(z2 + (size_t)(r - 1) * 2048 + 1024 + c0), m1); else { for (int j = 0; j < 8; ++j) m1[j] = 0.f; }
        if (l >= 2) unpack8(*(const u32x4*)(z2 + (size_t)(r - 2) * 2048 + 1024 + c0), m2); else { for (int j = 0; j < 8; ++j) m2[j] = 0.f; }
#pragma unroll
        for (int j = 0; j < 8; ++j) q[j] = gb[j] * (w0[j] * m2[j] + w1[j] * m1[j] + w2[j] * cur[j]);
        u32x4 w; w.x = cvt_pk_bf16(q[0], q[1]); w.y = cvt_pk_bf16(q[2], q[3]); w.z = cvt_pk_bf16(q[4], q[5]); w.w = cvt_pk_bf16(q[6], q[7]);
        *(u32x4*)(hA + (size_t)r * 1024 + c0) = w;
        if (l >= 2046) st8(P.out + O_CONV_P + (size_t)((r >> 11) * 2 + (l - 2046)) * 1024 + c0, cur);
    }
    for (int id = (G - 1 - (int)blockIdx.x) * NTHR + tidl_; id < NS * 128; id += G * NTHR) {
        const int n = id >> 7; float gb[8], gc[8], v[8], b0[8], b1[8], cvs[8], q[8];
        ld8(raw + (size_t)n * 3072 + c0, gb); ld8(raw + (size_t)n * 3072 + 1024 + pcol(c0), gc); ld8(raw + (size_t)n * 3072 + 1024 + pcol(c0) + 128, v);
        ld8(P.st_conv + (size_t)(n * 2) * 1024 + c0, b0); ld8(P.st_conv + (size_t)(n * 2 + 1) * 1024 + c0, b1);
#pragma unroll
        for (int j = 0; j < 8; ++j) { cvs[j] = gc[j] * v[j]; q[j] = gb[j] * (w0[j] * b0[j] + w1[j] * b1[j] + w2[j] * cvs[j]); }
        st8(P.out + O_CONV_S + (size_t)(n * 2) * 1024 + c0, b1); st8(P.out + O_CONV_S + (size_t)(n * 2 + 1) * 1024 + c0, cvs);
        u32x4 w; w.x = cvt_pk_bf16(q[0], q[1]); w.y = cvt_pk_bf16(q[2], q[3]); w.z = cvt_pk_bf16(q[4], q[5]); w.w = cvt_pk_bf16(q[6], q[7]);
        *(u32x4*)(hA + (size_t)(MP + n) * 1024 + c0) = w;
    }
}

#define XB_TMO      128
#define XB_XCNT(j)  (256  + 64 * (j))
#define XB_XSUB(j)  (1280 + 64 * (j))
#define XB_XGEN(j)  (2304 + 64 * (j))
#define XB_TOP      3328
#define XB_TOPGEN   3392
#define XCD_BAR_WORDS 3456
#define XB_SPIN_CAP (1u << 20)
__device__ __forceinline__ unsigned xb_ld(unsigned* p)              { return __hip_atomic_load(p, __ATOMIC_RELAXED, __HIP_MEMORY_SCOPE_AGENT); }
__device__ __forceinline__ unsigned xb_add(unsigned* p, unsigned v) { return __hip_atomic_fetch_add(p, v, __ATOMIC_RELAXED, __HIP_MEMORY_SCOPE_AGENT); }
__device__ __forceinline__ unsigned xb_xcc_id() { return (unsigned)__builtin_amdgcn_s_getreg((3 << 11) | 20) & 0xFu; }
#define XB_SPIN(cond, bar) do { unsigned _sp = 0; while (cond) { __builtin_amdgcn_s_sleep(1); \
    if ((++_sp & 255u) == 0u) { if (xb_ld(&(bar)[XB_TMO])) break; if (_sp > XB_SPIN_CAP) { atomicAdd(&(bar)[XB_TMO], 1u); break; } } } } while (0)
__device__ __forceinline__ void xcd_barrier_complete(unsigned* bar, unsigned x, unsigned& nloc, unsigned& nx) {
    const unsigned G = gridDim.x; unsigned sum, cnt, mine, sp = 0u;
    for (;;) {
        sum = 0u; cnt = 0u; mine = 0u;
#pragma unroll
        for (unsigned j = 0; j < 16; ++j) { const unsigned c = xb_ld(&bar[XB_XCNT(j)]); sum += c; cnt += (c > 0u) ? 1u : 0u; mine = (j == x) ? c : mine; }
        if (sum == G) break;
        __builtin_amdgcn_s_sleep(1);
        if ((++sp & 255u) == 0u) { if (xb_ld(&bar[XB_TMO])) break; if (sp > XB_SPIN_CAP) { atomicAdd(&bar[XB_TMO], 1u); break; } }
    }
    nloc = mine > 0u ? mine : 1u; nx = cnt > 0u ? cnt : 1u;
}
__device__ __forceinline__ void grid_bar(unsigned* bar, volatile LAS unsigned* st) {
    asm volatile("s_waitcnt vmcnt(0)" ::: "memory");
    __syncthreads();
    if (ltid() == 0) {
        const unsigned x = xb_xcc_id();
        __builtin_amdgcn_s_waitcnt(0);
        unsigned nloc = st[0], nx = st[1];
        if (nloc == 0u) { xcd_barrier_complete(bar, x, nloc, nx); st[0] = nloc; st[1] = nx; }
        const unsigned old = xb_add(&bar[XB_XSUB(x)], 1u);
        const unsigned gen = old / nloc;
        if (old + 1u == (gen + 1u) * nloc) {
            __builtin_amdgcn_fence(__ATOMIC_RELEASE, "agent");
            asm volatile("s_waitcnt vmcnt(0)" ::: "memory");
            const unsigned og = xb_add(&bar[XB_TOP], 1u);
            const unsigned tg = og / nx;
            if (og + 1u == (tg + 1u) * nx) xb_add(&bar[XB_TOPGEN], 1u);
            else XB_SPIN(xb_ld(&bar[XB_TOPGEN]) == tg, bar);
            __builtin_amdgcn_fence(__ATOMIC_ACQUIRE, "agent");
            xb_add(&bar[XB_XGEN(x)], 1u);
            asm volatile("s_waitcnt vmcnt(0)" ::: "memory");
        } else {
            XB_SPIN(xb_ld(&bar[XB_XGEN(x)]) == gen, bar);
            __builtin_amdgcn_fence(__ATOMIC_ACQUIRE, "agent");
            asm volatile("s_waitcnt vmcnt(0)" ::: "memory");
        }
    }
    __syncthreads();
}

__device__ __forceinline__ void sample_gate(KP& P, int slot) {
    const int r = (int)gridDim.x - 1 - (int)blockIdx.x; unsigned* c = (unsigned*)(P.ws + WS_CNT) + 3072 + 96 + slot * 16;
    asm volatile("s_waitcnt vmcnt(0)" ::: "memory"); __syncthreads();
    if (ltid() == 0) {
        if (r < 64) { __builtin_amdgcn_fence(__ATOMIC_RELEASE, "agent"); asm volatile("s_waitcnt vmcnt(0)" ::: "memory"); __hip_atomic_fetch_add(c, 1u, __ATOMIC_RELAXED, __HIP_MEMORY_SCOPE_AGENT); }
        if (r < 16) { unsigned spins = 0; while (__hip_atomic_load(c, __ATOMIC_RELAXED, __HIP_MEMORY_SCOPE_AGENT) < 64u) { __builtin_amdgcn_s_sleep(2); if (++spins > (1u << 22)) break; }
            __builtin_amdgcn_fence(__ATOMIC_ACQUIRE, "agent"); asm volatile("s_waitcnt vmcnt(0)" ::: "memory"); }
    }
    __syncthreads();
}

__global__ void __launch_bounds__(NTHR) fwd_kernel(Params P_unused) {
    LAS unsigned char* lds = (LAS unsigned char*)lds_raw;
    { const unsigned slot = (unsigned)__builtin_amdgcn_s_getreg((5 << 11) | 4) & 63u; if ((threadIdx.x & 63) == 0) ((volatile LAS int*)(lds + LDS_WTAB))[slot] = (int)(threadIdx.x >> 6); __syncthreads(); }
    const int G = gridDim.x, bx = blockIdx.x;
    const int lo = getP().ph_lo, hi = getP().ph_hi;
    if (lo < 0) cg::this_grid().sync();
#define BST ((volatile LAS unsigned*)((LAS unsigned char*)lds_raw + 131072 + 64))
    if (ltid() == 0) { BST[0] = 0u; BST[1] = 0u; if (hi - lo > 1) (void)xb_add(&((unsigned*)(getP().ws + WS_BAR))[XB_XCNT(xb_xcc_id())], 1u); }
    __syncthreads();
#define GBAR() do { grid_bar((unsigned*)(getP().ws + WS_BAR), BST); } while (0)
#define PHASE_VARS KP& P = getP(); unsigned char* ws = P.ws; const float* mods = (const float*)(ws + WS_MODS); bf16_t* hA = (bf16_t*)(ws + WS_H); float* T = (float*)(ws + WS_T); float* raw = (float*)(ws + WS_RAW); bf16_t* act = (bf16_t*)(ws + WS_BIG); \
    (void)mods; (void)hA; (void)T; (void)raw; (void)act;
#ifndef ONLYP
#define ONLYP (-1)
#endif
#define IN(k) ((ONLYP < 0 || (k) == ONLYP) && lo <= (k) && (k) < hi)
#define SEAM(k) do { if (IN(k) && IN((k) + 1)) { GBAR(); for (int xs_ = 0; xs_ < XSYNC; ++xs_) GBAR(); } } while (0)
#define MOD_OFF(i, j, k) ((((i) * 2 + (j)) * 3 + (k)) * 1024)

    if (IN(0)) for (int rep_ = 0; rep_ < 1 + (int)((REPMASK >> (0)) & 1u); ++rep_) { if (rep_) GBAR(); PHASE_VARS
        p0_s5_tables(P, (LAS float*)lds); __syncthreads();
        mods_phase(P, (LAS float*)lds, (G == 256) ? (bx >= 64 ? bx - 64 : (1 << 30)) : bx, (G == 256) ? 192 : G);
        p0_convert(P, (LAS float*)lds); } SEAM(0);
    if (IN(2)) for (int rep_ = 0; rep_ < 1 + (int)((REPMASK >> (2)) & 1u); ++rep_) { if (rep_) GBAR(); PHASE_VARS modulate_phase(P); } SEAM(2);
    if (IN(3)) for (int rep_ = 0; rep_ < 1 + (int)((REPMASK >> (3)) & 1u); ++rep_) { if (rep_) GBAR(); PHASE_VARS
        { Gemm g{hA, (const bf16_t*)(ws + WS_WIN), 1024, 1024, 1024}; StaticOrder S; S.init(MP, 1024, G, bx); EpiWin E{(bf16_t*)(ws + WS_T)}; gemm_phase(lds, g, S, E); }
        skinny3((LAS float*)lds, hA + (size_t)MP * 1024, 1024, (const bf16_t*)(ws + WS_WIN), 1024, raw, G - 1 - bx, G);
    } SEAM(3);
    if (IN(4)) for (int rep_ = 0; rep_ < 1 + (int)((REPMASK >> (4)) & 1u); ++rep_) { if (rep_) GBAR(); PHASE_VARS for (int q_ = 0; q_ < S5P_REP; ++q_) s5_prompt(P, lds); for (int q_ = 0; q_ < S5S_REP; ++q_) s5_sample(P); } SEAM(4);
    if (IN(5)) for (int rep_ = 0; rep_ < 1 + (int)((REPMASK >> (5)) & 1u); ++rep_) { if (rep_) GBAR(); PHASE_VARS
        { Gemm g{hA, (const bf16_t*)(ws + WS_WGLU), 1024, 1024, 1024}; StaticOrder S; S.init(MP, 2048, G, bx); EpiGlu E{P.x_p, mods + MOD_OFF(0, 0, 2), (bf16_t*)T}; gemm_phase(lds, g, S, E); }
        skinny3((LAS float*)lds, hA + (size_t)MP * 1024, 1024, (const bf16_t*)(ws + WS_WGLU), 2048, raw, G - 1 - bx, G);
    } SEAM(5);
    if (IN(6)) for (int rep_ = 0; rep_ < 1 + (int)((REPMASK >> (6)) & 1u); ++rep_) { if (rep_) GBAR(); PHASE_VARS ln_phase(P, 0, 0, 0, 1, P.x_s, MOD_OFF(0, 1, 0), true); } SEAM(6);
#pragma unroll 1
    for (int layer = 0; layer < 2; ++layer) {
        const int pb = layer ? 15 : 7;
        if (IN(pb)) for (int rep_ = 0; rep_ < 1 + (int)((REPMASK >> (pb)) & 1u); ++rep_) { if (rep_) GBAR(); PHASE_VARS
            { Gemm g{hA, (const bf16_t*)(ws + WS_UP) + (size_t)layer * DFF2 * 1024, 1024, 1024, 1024}; StaticOrder S; S.init(MP, DFF2, G, bx);
              EpiUp E{act, (bf16_t*)(ws + WS_BIG + BIG_HALO), P.out + O_FFN_P + (size_t)layer * NB * 2 * DFF2, P.ffn_conv_w + (size_t)layer * 3 * DFF2, P.ffn_conv_b + (size_t)layer * DFF2};
              gemm_phase(lds, g, S, E); }
            skinny_up(P, layer, (LAS float*)lds, hA + (size_t)MP * 1024, (const bf16_t*)(ws + WS_UP) + (size_t)layer * DFF2 * 1024, (G == 256) ? (bx >= 128 ? bx - 128 : (1 << 30)) : G - 1 - bx, (G == 256) ? 128 : G);
        } SEAM(pb);
        if (IN(pb + 2)) for (int rep_ = 0; rep_ < 1 + (int)((REPMASK >> (pb + 2)) & 1u); ++rep_) { if (rep_) GBAR(); PHASE_VARS
            { Gemm g{act, (const bf16_t*)(ws + WS_DOWN) + (size_t)layer * 1024 * DFF, DFF, DFF, DFF}; StaticOrder S; S.init(MP, 1024, G, bx);
              { Unit u0; if (S.next(0, u0)) ffn_fixup_rows(P, layer, u0.pm); }
              if (layer == 0) { EpiLnT<1, false> E{nullptr, (bf16_t*)(ws + WS_T + (size_t)32 * 1024 * 1024), (const bf16_t*)T, (const float*)(ws + WS_STATS), P.ln_g, P.ln_b, nullptr, mods, MOD_OFF(0, 1, 2), MOD_OFF(1, 0, 0), P.ln_g + 1024, P.ln_b + 1024, P.out + O_Y, hA, (unsigned long long*)(ws + WS_XBUF), (unsigned*)(ws + WS_CNT)};
                  gemm_phase(lds, g, S, E); }
              else { EpiLnT<2, true> E{(bf16_t*)(ws + WS_T + (size_t)32 * 1024 * 1024), nullptr, nullptr, nullptr, nullptr, nullptr, nullptr, mods, MOD_OFF(1, 1, 2), -1, P.ln_g + 3 * 1024, P.ln_b + 3 * 1024, P.out + O_Y, hA, (unsigned long long*)(ws + WS_XBUF), (unsigned*)(ws + WS_CNT) + 2048};
                  gemm_phase(lds, g, S, E); } }
            skinny3((LAS float*)lds, act + (size_t)MP * DFF, DFF, (const bf16_t*)(ws + WS_DOWN) + (size_t)layer * 1024 * DFF, 1024, raw, G - 1 - bx, G);
            if (G == 256) { sample_gate(P, layer ? 2 : 0); ln_phase(P, layer, 1, 1, 1, P.out + O_Y + (size_t)MP * 1024, layer ? -1 : MOD_OFF(1, 0, 0), false); }
        } if (layer == 0 || G != 256) SEAM(pb + 2);
        if (G != 256 && IN(pb + 3)) for (int rep_ = 0; rep_ < 1 + (int)((REPMASK >> (pb + 3)) & 1u); ++rep_) { if (rep_) GBAR(); PHASE_VARS ln_phase(P, layer, 1, 1, 1, P.out + O_Y + (size_t)MP * 1024, layer ? -1 : MOD_OFF(1, 0, 0), false); }
        if (layer == 0 && G != 256) SEAM(pb + 3);
        if (layer == 0) {
            if (IN(11)) for (int rep_ = 0; rep_ < 1 + (int)((REPMASK >> (11)) & 1u); ++rep_) { if (rep_) GBAR(); PHASE_VARS
                { Gemm g{hA, (const bf16_t*)(ws + WS_SCIN) + (size_t)1024 * 1024, 1024, 1024, 1024}; StaticOrder S; S.init(MP, 2048, G, bx); EpiCv E{(bf16_t*)(ws + WS_BIG)}; gemm_phase(lds, g, S, E); }
                { Gemm g{hA, (const bf16_t*)(ws + WS_SCIN), 1024, 1024, 1024}; StaticOrder S; S.init(MP, 1024, G, bx); EpiGateB E{(bf16_t*)(ws + WS_BIG)}; gemm_phase(lds, g, S, E); }
                skinny3((LAS float*)lds, hA + (size_t)MP * 1024, 1024, (const bf16_t*)(ws + WS_SCIN), 3072, raw, G - 1 - bx, G);
            } SEAM(11);
            if (IN(12)) for (int rep_ = 0; rep_ < 1 + (int)((REPMASK >> (12)) & 1u); ++rep_) { if (rep_) GBAR(); PHASE_VARS shortconv_phase(P); } SEAM(12);
            if (IN(13)) for (int rep_ = 0; rep_ < 1 + (int)((REPMASK >> (13)) & 1u); ++rep_) { if (rep_) GBAR(); PHASE_VARS
                { Gemm g{hA, (const bf16_t*)(ws + WS_SCOUT), 1024, 1024, 1024}; StaticOrder S; S.init(MP, 1024, G, bx);
                  EpiLnT<2, false> E{(bf16_t*)(ws + WS_T + (size_t)32 * 1024 * 1024), (bf16_t*)(ws + WS_T + (size_t)32 * 1024 * 1024), nullptr, nullptr, nullptr, nullptr, nullptr, mods, MOD_OFF(1, 0, 2), MOD_OFF(1, 1, 0), P.ln_g + 2 * 1024, P.ln_b + 2 * 1024, P.out + O_Y, hA, (unsigned long long*)(ws + WS_XBUF), (unsigned*)(ws + WS_CNT) + 1024};
                  gemm_phase(lds, g, S, E); }
                skinny3((LAS float*)lds, hA + (size_t)MP * 1024, 1024, (const bf16_t*)(ws + WS_SCOUT), 1024, raw, G - 1 - bx, G);
                if (G == 256) { sample_gate(P, 1); ln_phase(P, 1, 0, 1, 1, P.out + O_Y + (size_t)MP * 1024, MOD_OFF(1, 1, 0), false); }
            } SEAM(13);
            if (G != 256 && IN(14)) for (int rep_ = 0; rep_ < 1 + (int)((REPMASK >> (14)) & 1u); ++rep_) { if (rep_) GBAR(); PHASE_VARS ln_phase(P, 1, 0, 1, 1, P.out + O_Y + (size_t)MP * 1024, MOD_OFF(1, 1, 0), false); } if (G != 256) SEAM(14);
        }
    }
}

extern "C" void kernel_launch(void* const* d_in, const int* in_sizes, int n_in, void* d_out, int out_size, void* d_ws, size_t ws_size, hipStream_t stream) {
    static int grid = 0;
    if (grid == 0) {
        if (n_in != 29 || (size_t)out_size != O_END || ws_size < WS_END) { fprintf(stderr, "kernel_launch: unexpected shapes: n_in %d out %d ws %zu (need %zu)\n", n_in, out_size, ws_size, (size_t)WS_END); grid = -1; return; }
        int dev = 0, cus = 0, per_cu = 0;
        hipGetDevice(&dev); hipDeviceGetAttribute(&cus, hipDeviceAttributeMultiprocessorCount, dev);
        if (hipFuncSetAttribute((const void*)fwd_kernel, hipFuncAttributeMaxDynamicSharedMemorySize, LDS_BYTES) != hipSuccess) { fprintf(stderr, "kernel_launch: hipFuncSetAttribute failed\n"); grid = -1; return; }
        if (hipOccupancyMaxActiveBlocksPerMultiprocessor(&per_cu, (const void*)fwd_kernel, NTHR, LDS_BYTES) != hipSuccess || per_cu < 1) { fprintf(stderr, "kernel_launch: occupancy query gives %d\n", per_cu); per_cu = 1; }
        (void)hipGetLastError();
        grid = cus;
    }
    if (grid < 0) return;
    Params p{};
    const float** pp = (const float**)&p;
    for (int i = 0; i < 29; ++i) pp[i] = (const float*)d_in[i];
    p.out = (float*)d_out; p.ws = (unsigned char*)d_ws;
#if ONE_LAUNCH
    p.ph_lo = 0; p.ph_hi = NPHASE;
    if (hipMemsetAsync((char*)d_ws + WS_BAR, 0, 32768, stream) != hipSuccess) { fprintf(stderr, "kernel_launch: memset of the barrier word failed\n"); return; }
    void* args[] = {&p};
    hipError_t e = hipLaunchCooperativeKernel((const void*)fwd_kernel, dim3(grid), dim3(NTHR), args, LDS_BYTES, stream);
    if (e != hipSuccess) fprintf(stderr, "cooperative launch failed: %s (grid %d)\n", hipGetErrorString(e), grid);
#else
    for (int ph = 0; ph < NPHASE; ++ph) { p.ph_lo = ph; p.ph_hi = ph + 1; hipLaunchKernelGGL(fwd_kernel, dim3(grid), dim3(NTHR), LDS_BYTES, stream, p); }
#endif
}
```
